# Optimizing an MI355X kernel written in HIP

```python
import jax
import jax.numpy as jnp
from jax import lax
import numpy as np

D_MODEL = 1024
BATCH = 2
SEQ = 8192
DEPTH = 1

GRID_W = 64
CTX_LEN = 256
EPS = 1e-6

A_WIDTH = 512
A_GROUPS = 4
A_GROUP_DIM = A_WIDTH // A_GROUPS
A_CHUNK = 128
A_ROW_GROUPS = 2

B_HEADS = 4
B_DK = 64
B_DV = 128
B_KEY_WIDTH = B_HEADS * B_DK
B_VAL_WIDTH = B_HEADS * B_DV
B_GATE_RANK = 16
B_GATE_TAU = 16.0
B_CHUNK = 64

Q0 = 0
K0 = Q0 + B_KEY_WIDTH
V0 = K0 + B_KEY_WIDTH
LR0 = V0 + B_VAL_WIDTH
ZB0 = LR0 + 2 * B_GATE_RANK
UA0 = ZB0 + B_VAL_WIDTH
VA0 = UA0 + A_WIDTH
ZA0 = VA0 + A_WIDTH
G0 = ZA0 + A_WIDTH
IN_WIDTH = G0 + 2 * D_MODEL

kernel_name = "hybrid_gmlp_gla_prefix_block"


def rmsnorm(x, g):
    xf = x.astype(jnp.float32)
    y = xf * lax.rsqrt(jnp.mean(xf * xf, axis=-1, keepdims=True) + EPS)
    return (y * g.astype(jnp.float32)).astype(x.dtype)


def layernorm(x, g, b):
    xf = x.astype(jnp.float32)
    xc = xf - jnp.mean(xf, axis=-1, keepdims=True)
    y = xc * lax.rsqrt(jnp.mean(xc * xc, axis=-1, keepdims=True) + EPS)
    return (y * g.astype(jnp.float32) + b.astype(jnp.float32)).astype(x.dtype)


def spatial_mix(vg, ws, bs):
    b, l, g, dg = vg.shape
    vr = vg.reshape(b, l // A_CHUNK, A_CHUNK, g, dg)
    s = jnp.einsum('gij,bnjgc->bnigc', ws, vr) + bs.T[None, None, :, :, None]
    return s.reshape(b, l, g, dg)


def to_colmajor(t, rows):
    b, l, g, dg = t.shape
    return t.reshape(b, rows, GRID_W, g, dg).transpose(0, 2, 1, 3, 4).reshape(b, l, g, dg)


def from_colmajor(t, rows):
    b, l, g, dg = t.shape
    return t.reshape(b, GRID_W, rows, g, dg).transpose(0, 2, 1, 3, 4).reshape(b, l, g, dg)


def chunk_mlp_branch(p, rows, ln_g, ln_b, ws, bs, w_proj):
    b, l, _ = p.shape
    u = p[..., UA0:VA0]
    z = p[..., ZA0:G0]
    vn = layernorm(p[..., VA0:ZA0], ln_g, ln_b).reshape(b, l, A_GROUPS, A_GROUP_DIM)
    if rows is None:
        sv = spatial_mix(vn, ws, bs)
    else:
        r = A_ROW_GROUPS
        sv_row = spatial_mix(vn[:, :, :r], ws[:r], bs[:r])
        sv_col = from_colmajor(spatial_mix(to_colmajor(vn[:, :, r:], rows), ws[r:], bs[r:]), rows)
        sv = jnp.concatenate([sv_row, sv_col], axis=2)
    return (u * sv.reshape(b, l, A_WIDTH) * jax.nn.silu(z)) @ w_proj


def to_chunks(t):
    b, l, h, d = t.shape
    return t.reshape(b, l // B_CHUNK, B_CHUNK, h, d).transpose(0, 3, 1, 2, 4)


def from_chunks(t):
    b, h, n, c, d = t.shape
    return t.transpose(0, 2, 3, 1, 4).reshape(b, n * c, h, d)


def gla_states(kc, vc, ac, s0):
    cum = jnp.cumsum(ac, axis=3)
    cum_last = cum[:, :, :, -1]
    k_dec = kc * jnp.exp(cum_last[:, :, :, None] - cum)
    kv = jnp.einsum('bhncd,bhnce->bhnde', k_dec, vc)

    def step(s, inp):
        decay, upd = inp
        return decay[..., None] * s + upd, s

    s_final, s_before = lax.scan(step, s0, (jnp.moveaxis(jnp.exp(cum_last), 2, 0), jnp.moveaxis(kv, 2, 0)))
    return s_final, jnp.moveaxis(s_before, 0, 2), cum


def gla_chunk_outputs(qc, kc, vc, cum, s_before):
    qd = qc * jnp.exp(cum)
    kd = kc * jnp.exp(-cum)
    scores = jnp.einsum('bhnid,bhnjd->bhnij', qd, kd)
    mask = jnp.tril(jnp.ones((B_CHUNK, B_CHUNK), dtype=bool))
    scores = jnp.where(mask, scores, 0.0)
    return jnp.einsum('bhnij,bhnje->bhnie', scores, vc) + jnp.einsum('bhnid,bhnde->bhnie', qd, s_before)


def gla_direction(q, k, v, log_a, s0, reverse):
    if reverse:
        k, v, log_a = jnp.flip(k, 1), jnp.flip(v, 1), jnp.flip(log_a, 1)
        if q is not None:
            q = jnp.flip(q, 1)
    kc, vc, ac = to_chunks(k), to_chunks(v), to_chunks(log_a)
    s_final, s_before, cum = gla_states(kc, vc, ac, s0)
    if q is None:
        return None, s_final
    o = from_chunks(gla_chunk_outputs(to_chunks(q), kc, vc, cum, s_before))
    if reverse:
        o = jnp.flip(o, 1)
    return o, s_final


def gla_q(p):
    b, l, _ = p.shape
    return p[..., Q0:K0].reshape(b, l, B_HEADS, B_DK).astype(jnp.float32) * (B_DK ** -0.5)


def gla_kva(p, base, w2, gb):
    b, l, _ = p.shape
    k = p[..., K0 - base:V0 - base].reshape(b, l, B_HEADS, B_DK).astype(jnp.float32)
    v = p[..., V0 - base:LR0 - base].reshape(b, l, B_HEADS, B_DV).astype(jnp.float32)
    lr = p[..., LR0 - base:ZB0 - base].reshape(b, l, 2, B_GATE_RANK)
    logits = jnp.einsum('blrk,rkd->blrd', lr, w2) + gb
    log_a = (jax.nn.log_sigmoid(logits.astype(jnp.float32)) / B_GATE_TAU).reshape(b, l, 2, B_HEADS, B_DK)
    return k, v, log_a[:, :, 0], log_a[:, :, 1]


def gla_branch_out(o, z, g, w_proj):
    b, l, _, _ = o.shape
    on = o * lax.rsqrt(jnp.mean(o * o, axis=-1, keepdims=True) + EPS) * g.reshape(B_HEADS, B_DV).astype(jnp.float32)
    on = on.reshape(b, l, B_VAL_WIDTH).astype(z.dtype)
    return (on * jax.nn.silu(z)) @ w_proj


def merge_branches(p, ya, yb, w_out):
    g = jax.nn.sigmoid(p[..., G0:])
    return (g[..., :D_MODEL] * ya + g[..., D_MODEL:] * yb) @ w_out


def setup_inputs(seed: int = 0) -> dict:
    key = jax.random.key(seed)
    ks = jax.random.split(key, 20)

    def nrm(k, shape, s):
        return jax.random.normal(k, shape, jnp.float32) * s

    return {
        "x": nrm(ks[0], (BATCH, SEQ, D_MODEL), 1.0),
        "c": nrm(ks[1], (BATCH, D_MODEL), 1.0),
        "ctx": nrm(ks[2], (BATCH, CTX_LEN, D_MODEL), 1.0),
        "c_ctx": nrm(ks[3], (D_MODEL,), 1.0),
        "w_mod": nrm(ks[4], (DEPTH, D_MODEL, 3 * D_MODEL), D_MODEL ** -0.5),
        "b_mod": nrm(ks[5], (DEPTH, 3 * D_MODEL), 0.01),
        "norm_g": 1.0 + nrm(ks[6], (DEPTH, D_MODEL), 0.01),
        "w_in": nrm(ks[7], (DEPTH, D_MODEL, IN_WIDTH), D_MODEL ** -0.5),
        "a_ln_g": 1.0 + nrm(ks[8], (DEPTH, A_WIDTH), 0.01),
        "a_ln_b": nrm(ks[9], (DEPTH, A_WIDTH), 0.01),
        "a_ws": nrm(ks[10], (DEPTH, A_GROUPS, A_CHUNK, A_CHUNK), A_CHUNK ** -0.5),
        "a_bs": 1.0 + nrm(ks[11], (DEPTH, A_GROUPS, A_CHUNK), 0.01),
        "b_gate_w2": nrm(ks[12], (DEPTH, 2, B_GATE_RANK, B_KEY_WIDTH), B_GATE_RANK ** -0.5),
        "b_gate_b": nrm(ks[13], (DEPTH, 2, B_KEY_WIDTH), 0.1),
        "b_norm_g": 1.0 + nrm(ks[14], (DEPTH, B_VAL_WIDTH), 0.01),
        "w_proj_a": nrm(ks[15], (DEPTH, A_WIDTH, D_MODEL), A_WIDTH ** -0.5),
        "w_proj_b": nrm(ks[16], (DEPTH, B_VAL_WIDTH, D_MODEL), B_VAL_WIDTH ** -0.5),
        "w_out": nrm(ks[17], (DEPTH, D_MODEL, D_MODEL), D_MODEL ** -0.5),
        "final_norm_g": 1.0 + nrm(ks[18], (D_MODEL,), 0.01),
    }


def reference(x, c, ctx, c_ctx, w_mod, b_mod, norm_g, w_in, a_ln_g, a_ln_b, a_ws, a_bs,
              b_gate_w2, b_gate_b, b_norm_g, w_proj_a, w_proj_b, w_out, final_norm_g):
    rows = x.shape[1] // GRID_W
    xc = ctx
    for layer in range(DEPTH):
        last = layer == DEPTH - 1
        wm, bm, wi = w_mod[layer], b_mod[layer], w_in[layer]

        mod = jax.nn.silu(c) @ wm + bm
        shift, scale, gate = jnp.split(mod, 3, axis=-1)
        h = rmsnorm(x, norm_g[layer]) * (1 + scale[:, None]) + shift[:, None]
        p = h @ wi

        n_mod = (2 if last else 3) * D_MODEL
        mod_c = jax.nn.silu(c_ctx) @ wm[:, :n_mod] + bm[:n_mod]
        hc = rmsnorm(xc, norm_g[layer]) * (1 + mod_c[D_MODEL:2 * D_MODEL]) + mod_c[:D_MODEL]
        base_c = K0 if last else 0
        pc = hc @ (wi[:, K0:ZB0] if last else wi)

        kc, vc, ac_f, ac_b = gla_kva(pc, base_c, b_gate_w2[layer], b_gate_b[layer])
        qc = None if last else gla_q(pc)
        s0 = jnp.zeros((xc.shape[0], B_HEADS, B_DK, B_DV), jnp.float32)
        oc_f, sc_f = gla_direction(qc, kc, vc, ac_f, s0, False)
        oc_b, sc_b = gla_direction(qc, kc, vc, ac_b, s0, True)

        k, v, a_f, a_b = gla_kva(p, 0, b_gate_w2[layer], b_gate_b[layer])
        q = gla_q(p)
        o_f, _ = gla_direction(q, k, v, a_f, sc_f, False)
        o_b, _ = gla_direction(q, k, v, a_b, sc_b, True)
        yb = gla_branch_out(o_f + o_b, p[..., ZB0:UA0], b_norm_g[layer], w_proj_b[layer])

        ya = chunk_mlp_branch(p, rows, a_ln_g[layer], a_ln_b[layer], a_ws[layer], a_bs[layer], w_proj_a[layer])

        x = x + gate[:, None] * merge_branches(p, ya, yb, w_out[layer])

        if not last:
            ybc = gla_branch_out(oc_f + oc_b, pc[..., ZB0:UA0], b_norm_g[layer], w_proj_b[layer])
            yac = chunk_mlp_branch(pc, None, a_ln_g[layer], a_ln_b[layer], a_ws[layer], a_bs[layer], w_proj_a[layer])
            xc = xc + mod_c[2 * D_MODEL:] * merge_branches(pc, yac, ybc, w_out[layer])
    return rmsnorm(x, final_norm_g)
```

```cpp
#include <hip/hip_runtime.h>
#include <hip/hip_cooperative_groups.h>
#include <cstdio>
#include <cstdint>
namespace cg = cooperative_groups;

namespace pg8 {
#define PG8_LAS __attribute__((address_space(3)))
typedef unsigned short bf16_t;
typedef short bf16x8 __attribute__((ext_vector_type(8)));
typedef float f32x4 __attribute__((ext_vector_type(4)));
typedef unsigned u32x4 __attribute__((ext_vector_type(4)));
constexpr int BM = 256, BK = 64, HALF = 128, HTB = HALF * BK * 2, STAGE_BYTES = 8 * HTB, NXCD = 8, WGM = 8;

__host__ __device__ __forceinline__ int lds_byte(int r, int c) { const int st = (r >> 4) * 2 + (c >> 5), rr = r & 15, cc = c & 31, ob = rr * 64 + cc * 2; return st * 1024 + (ob ^ (((ob >> 9) & 1) << 5)); }
__host__ __device__ __forceinline__ void stage_rc(int b, int& R, int& C) { const int st = b / 1024, sb = b % 1024, swz = sb ^ (((sb >> 9) & 1) << 5); R = (st >> 1) * 16 + swz / 64; C = (st & 1) * 32 + (swz % 64) / 2; }
__host__ __device__ __forceinline__ int perm32(int rho) { const int n = rho >> 4, i = rho & 15; return 8 * (i >> 2) + 4 * n + (i & 3); }

struct Unit { int pm, pn; };
struct Gemm { const bf16_t* A; const bf16_t* Bt; int M, N, K; };

struct StaticOrder {
    int nM, nN, nwg, G, c;
    __host__ __device__ void init(int M, int N, int G_, int c_) { nM = M / BM; nN = N / BM; nwg = nM * nN; G = G_; c = c_; }
    __host__ __device__ bool next(int i, Unit& u) const {
        const long L = (long)i * G + c; if (L >= nwg) return false;
        int wgid = (int)L; { const int q = nwg / NXCD, r = nwg % NXCD, xcd = wgid % NXCD, off = wgid / NXCD; wgid = (xcd < r ? xcd * (q + 1) : r * (q + 1) + (xcd - r) * q) + off; }
        const int nig = WGM * nN, gid = wgid / nig, fm = gid * WGM, gsz = (nM - fm) < WGM ? (nM - fm) : WGM;
        u.pm = fm + ((wgid % nig) % gsz); u.pn = (wgid % nig) / gsz; return true;
    }
    __device__ __forceinline__ void a_ready(const Unit&) const {}
    __device__ __forceinline__ void done(const Unit&) const {}
};
typedef __bf16 bf16v2_t __attribute__((ext_vector_type(2)));
typedef float f32v2_t __attribute__((ext_vector_type(2)));
__device__ __forceinline__ unsigned cvt_pk_bf16(float lo, float hi) { const f32v2_t v = {lo, hi}; return __builtin_bit_cast(unsigned, __builtin_convertvector(v, bf16v2_t)); }

template <class Epi, class Sched, bool ALIGN_EPI = false, bool SP2 = false>
__device__ __forceinline__ void gemm_phase(PG8_LAS unsigned char* lds, const Gemm g, const Sched& S, const Epi& E) {
    const int tid = threadIdx.x, wid = __builtin_amdgcn_readfirstlane(tid >> 6), lane = tid & 63, wr = wid >> 2, wc = wid & 3, fr = lane & 15, fq = lane >> 4;
    const int K = g.K, nt = K / BK;
    unsigned voffA[2], voffB[2];
#pragma unroll
    for (int i = 0; i < 2; ++i) { int R, C; stage_rc(tid * 16 + i * 8192, R, C); const int Rb = Epi::PERM ? ((R & ~31) + perm32(R & 31)) : R;
        voffA[i] = (unsigned)(R * K + C) * 2u; voffB[i] = (unsigned)(Rb * K + C) * 2u; }
    const size_t kstep = (size_t)(BK * 2);
    const size_t hstep = (size_t)HALF * K * 2;
    const size_t tstep = 2 * hstep;
    const unsigned ldsw = (unsigned)wid * 1024u;
    const int aoff = lds_byte(wr * 64 + fr, fq * 8), boff = lds_byte(wc * 32 + fr, fq * 8);
#define PG8_SA(b, h) (((b) * 2 + (h)) * HTB)
#define PG8_SB(b, h) ((4 + (b) * 2 + (h)) * HTB)
#define PG8_STAGE(bufoff, gbase, voff) do { _Pragma("unroll") for (int _i = 0; _i < 2; ++_i) \
        __builtin_amdgcn_global_load_lds((const unsigned*)((const char*)(gbase) + (voff)[_i]), (PG8_LAS unsigned*)(lds + (bufoff) + ldsw + _i * 8192), 16, 0, 0); } while (0)
#define PG8_LDA(dst, b, h) do { _Pragma("unroll") for (int m = 0; m < 4; ++m) _Pragma("unroll") for (int k = 0; k < 2; ++k) dst[m][k] = *(const PG8_LAS bf16x8*)(lds + PG8_SA(b, h) + aoff + m * 2048 + k * 1024); } while (0)
#define PG8_LDB(dst, b, h) do { _Pragma("unroll") for (int n = 0; n < 2; ++n) _Pragma("unroll") for (int k = 0; k < 2; ++k) dst[n][k] = *(const PG8_LAS bf16x8*)(lds + PG8_SB(b, h) + boff + n * 2048 + k * 1024); } while (0)
#define PG8_MMA(ai, bj, At, Bt) do { __builtin_amdgcn_s_setprio(1); _Pragma("unroll") for (int m = 0; m < 4; ++m) _Pragma("unroll") for (int n = 0; n < 2; ++n) _Pragma("unroll") for (int k = 0; k < 2; ++k) \
        acc[ai][bj][m][n] = __builtin_amdgcn_mfma_f32_16x16x32_bf16(Bt[n][k], At[m][k], acc[ai][bj][m][n], 0, 0, 0); __builtin_amdgcn_s_setprio(0); } while (0)
#define PG8_WAIT_V(n) asm volatile("s_waitcnt vmcnt(" #n ")" ::: "memory")
#define PG8_WAIT_L(n) asm volatile("s_waitcnt lgkmcnt(" #n ")" ::: "memory")
#define PG8_BAR __builtin_amdgcn_s_barrier()
#define PG8_SCHED __builtin_amdgcn_sched_barrier(0)
    Unit cur, nxt; int ui = 0;
    if (!S.next(0, cur)) return;
    f32x4 acc[2][2][4][2];
#pragma unroll
    for (int a = 0; a < 2; ++a)
#pragma unroll
        for (int b = 0; b < 2; ++b)
#pragma unroll
            for (int m = 0; m < 4; ++m)
#pragma unroll
                for (int n = 0; n < 2; ++n) acc[a][b][m][n] = (f32x4){0.f, 0.f, 0.f, 0.f};
    bf16x8 At[4][2], B0[2][2], B1[2][2];
    const char* cA = (const char*)g.A + (size_t)cur.pm * tstep; const char* cB = (const char*)g.Bt + (size_t)cur.pn * tstep;
    S.a_ready(cur);
    if constexpr (SP2) {
        PG8_STAGE(PG8_SB(0, 0), cB, voffB); PG8_STAGE(PG8_SB(0, 1), cB + hstep, voffB); PG8_STAGE(PG8_SA(0, 0), cA, voffA); PG8_STAGE(PG8_SA(0, 1), cA + hstep, voffA);
        if (wr == 1) PG8_BAR;
        PG8_WAIT_V(2); PG8_BAR;
        PG8_STAGE(PG8_SB(1, 0), cB + kstep, voffB); PG8_STAGE(PG8_SA(1, 0), cA + kstep, voffA); PG8_STAGE(PG8_SB(1, 1), cB + hstep + kstep, voffB);
        PG8_WAIT_V(6); PG8_BAR;
    } else {
        PG8_STAGE(PG8_SB(0, 0), cB, voffB); PG8_STAGE(PG8_SA(0, 0), cA, voffA); PG8_STAGE(PG8_SB(0, 1), cB + hstep, voffB); PG8_STAGE(PG8_SA(0, 1), cA + hstep, voffA);
        if (wr == 1) PG8_BAR;
        PG8_WAIT_V(4); PG8_BAR;
        PG8_STAGE(PG8_SB(1, 0), cB + kstep, voffB); PG8_STAGE(PG8_SA(1, 0), cA + kstep, voffA); PG8_STAGE(PG8_SB(1, 1), cB + hstep + kstep, voffB);
        PG8_WAIT_V(6); PG8_BAR;
    }
    for (;;) {
        const bool has_next = S.next(ui + 1, nxt);
        const char* nA = has_next ? (const char*)g.A + (size_t)nxt.pm * tstep : cA; const char* nB = has_next ? (const char*)g.Bt + (size_t)nxt.pn * tstep : cB;
        for (int t = 0; t < nt; t += 2) {
            const bool last = (t == nt - 2);
            const char* a1 = cA + (size_t)(t + 1) * kstep;
            const char* a2 = last ? nA : cA + (size_t)(t + 2) * kstep; const char* b2 = last ? nB : cB + (size_t)(t + 2) * kstep;
            const char* a3 = a2 + kstep; const char* b3 = b2 + kstep;
            if (last && has_next) S.a_ready(nxt);
            if constexpr (Epi::MID) { if (t == (nt >> 1)) E.mid(acc, cur, wr, wc, fr, fq); }
            if constexpr (SP2) {
            PG8_LDB(B0, 0, 0); PG8_LDB(B1, 0, 1); PG8_SCHED; PG8_LDA(At, 0, 0); PG8_STAGE(PG8_SA(1, 1), a1 + hstep, voffA);
            PG8_WAIT_V(8); PG8_WAIT_L(0); PG8_BAR; PG8_MMA(0, 0, At, B0); PG8_MMA(0, 1, At, B1); PG8_BAR; PG8_SCHED;
            PG8_LDA(At, 0, 1); PG8_STAGE(PG8_SB(0, 0), b2, voffB); PG8_STAGE(PG8_SB(0, 1), b2 + hstep, voffB); PG8_STAGE(PG8_SA(0, 0), a2, voffA);
            PG8_WAIT_V(8); PG8_WAIT_L(0); PG8_BAR; PG8_MMA(1, 0, At, B0); PG8_MMA(1, 1, At, B1); PG8_BAR; PG8_SCHED;
            PG8_LDB(B0, 1, 0); PG8_LDB(B1, 1, 1); PG8_SCHED; PG8_LDA(At, 1, 0); PG8_STAGE(PG8_SA(0, 1), a2 + hstep, voffA);
            PG8_WAIT_V(8); PG8_WAIT_L(0); PG8_BAR; PG8_MMA(0, 0, At, B0); PG8_MMA(0, 1, At, B1); PG8_BAR; PG8_SCHED;
            PG8_LDA(At, 1, 1); PG8_STAGE(PG8_SB(1, 0), b3, voffB); PG8_STAGE(PG8_SB(1, 1), b3 + hstep, voffB); PG8_STAGE(PG8_SA(1, 0), a3, voffA);
            PG8_WAIT_V(8); PG8_WAIT_L(0); PG8_BAR; PG8_MMA(1, 0, At, B0); PG8_MMA(1, 1, At, B1); PG8_BAR; PG8_SCHED;
            } else {
            PG8_LDB(B0, 0, 0); PG8_SCHED; PG8_LDA(At, 0, 0); PG8_STAGE(PG8_SA(1, 1), a1 + hstep, voffA);
            PG8_WAIT_L(8); PG8_BAR; PG8_WAIT_L(0); PG8_MMA(0, 0, At, B0); PG8_BAR; PG8_SCHED;
            PG8_LDB(B1, 0, 1); PG8_STAGE(PG8_SB(0, 0), b2, voffB);
            PG8_BAR; PG8_WAIT_L(0); PG8_MMA(0, 1, At, B1); PG8_BAR;
            PG8_LDA(At, 0, 1); PG8_STAGE(PG8_SA(0, 0), a2, voffA);
            PG8_BAR; PG8_WAIT_L(0); PG8_MMA(1, 0, At, B0); PG8_BAR; PG8_SCHED;
            PG8_STAGE(PG8_SB(0, 1), b2 + hstep, voffB);
            PG8_WAIT_V(6); PG8_BAR; PG8_MMA(1, 1, At, B1); PG8_BAR;
            PG8_LDB(B0, 1, 0); PG8_SCHED; PG8_LDA(At, 1, 0); PG8_STAGE(PG8_SA(0, 1), a2 + hstep, voffA);
            PG8_WAIT_L(8); PG8_BAR; PG8_WAIT_L(0); PG8_MMA(0, 0, At, B0); PG8_BAR; PG8_SCHED;
            PG8_LDB(B1, 1, 1); PG8_STAGE(PG8_SB(1, 0), b3, voffB);
            PG8_BAR; PG8_WAIT_L(0); PG8_MMA(0, 1, At, B1); PG8_BAR;
            PG8_LDA(At, 1, 1); PG8_STAGE(PG8_SA(1, 0), a3, voffA);
            PG8_BAR; PG8_WAIT_L(0); PG8_MMA(1, 0, At, B0); PG8_BAR; PG8_SCHED;
            PG8_STAGE(PG8_SB(1, 1), b3 + hstep, voffB);
            PG8_WAIT_V(6); PG8_BAR; PG8_MMA(1, 1, At, B1); PG8_BAR;
            }
        }
        if constexpr (ALIGN_EPI) { if (wr == 0) PG8_BAR; }
        if constexpr (!Epi::AFTER_DRAIN) { E(acc, cur, wr, wc, fr, fq); S.done(cur); }
        if (!has_next) break;
#pragma unroll
        for (int a = 0; a < 2; ++a)
#pragma unroll
            for (int b = 0; b < 2; ++b)
#pragma unroll
                for (int m = 0; m < 4; ++m)
#pragma unroll
                    for (int n = 0; n < 2; ++n) acc[a][b][m][n] = (f32x4){0.f, 0.f, 0.f, 0.f};
        cur = nxt; cA = nA; cB = nB; ++ui;
        if constexpr (ALIGN_EPI) { if (wr == 1) PG8_BAR; }
    }
    PG8_WAIT_V(0);
    if constexpr (!ALIGN_EPI) { if (wr == 0) PG8_BAR; }
    PG8_BAR;
    if constexpr (Epi::AFTER_DRAIN) { E.fused(acc, cur, wr, wc, fr, fq, lds, wid, lane); S.done(cur); }
#undef PG8_SA
#undef PG8_SB
#undef PG8_STAGE
#undef PG8_LDA
#undef PG8_LDB
#undef PG8_MMA
#undef PG8_WAIT_V
#undef PG8_WAIT_L
#undef PG8_BAR
#undef PG8_SCHED
}

}

#define LAS __attribute__((address_space(3)))
typedef unsigned short bf16;
typedef unsigned v4u __attribute__((ext_vector_type(4)));
typedef unsigned v2u __attribute__((ext_vector_type(2)));
typedef float f32x4 __attribute__((ext_vector_type(4)));
typedef float f32x2 __attribute__((ext_vector_type(2)));
typedef short bf16x8 __attribute__((ext_vector_type(8)));
typedef short bf16x4 __attribute__((ext_vector_type(4)));

constexpr int NTHR = 512;
constexpr int D = 1024, SEQ = 8192, M = 16384, CTXR = 512;
constexpr int NP = 5120;
constexpr int CQ = 0, CK = 256, CV = 512, CZB = 1024, CUA = 1536, CVA = 2048, CZA = 2560, CG = 3072;
constexpr int INW = 5152;
constexpr float EPS = 1e-6f;
constexpr size_t MiB = 1u << 20;
constexpr size_t WS_MOD = 0, WS_MODC = 32768, WS_LRC = 65536, WS_PCKV = 131072, WS_LR = 1 * MiB, WS_PART = 3 * MiB, WS_DEC = 4 * MiB, WS_TOT = 4 * MiB + 640 * 1024, WS_BAR = 4 * MiB + 960 * 1024, WS_MODP = 5 * MiB + 512 * 1024,
                 WS_WSB = 5 * MiB, WS_WLR = 5 * MiB + 256 * 1024, WS_W2T = 6 * MiB, WS_WOT = 8 * MiB, WS_WIT = 10 * MiB, WS_KV = 20 * MiB, WS_MBUF = 20 * MiB,
                 WS_P = 54 * MiB, WS_END = 214 * MiB;
constexpr size_t OUT_H = 0, OUT_SB = 32 * MiB;
constexpr int NSLOT = 132;
constexpr int LDS_BYTES = 157696;

struct Params {
    const float *x, *c, *ctx, *c_ctx, *w_mod, *b_mod, *norm_g, *w_in, *a_ln_g, *a_ln_b, *a_ws, *a_bs, *gw2, *gb, *bng, *wpa, *wpb, *w_out, *fng;
    float* out; unsigned char* ws; int ph_lo, ph_hi;
};

__device__ __forceinline__ unsigned pk2(float lo, float hi) { return pg8::cvt_pk_bf16(lo, hi); }
__device__ __forceinline__ float bflo(unsigned u) { return __builtin_bit_cast(float, u << 16); }
__device__ __forceinline__ float bfhi(unsigned u) { return __builtin_bit_cast(float, u & 0xffff0000u); }
__device__ __forceinline__ float bf1(bf16 b) { return __builtin_bit_cast(float, ((unsigned)b) << 16); }
__device__ __forceinline__ float wave_sum(float v) {
#pragma unroll
    for (int o = 1; o < 64; o <<= 1) v += __shfl_xor(v, o);
    return v;
}
__device__ __forceinline__ float sigmoidf_(float v) { return __builtin_amdgcn_rcpf(1.0f + __expf(-v)); }
__device__ __forceinline__ float siluf_(float v) { return v * sigmoidf_(v); }
__device__ __forceinline__ float logsigf_(float v) { return fminf(v, 0.0f) - __logf(1.0f + __expf(-fabsf(v))); }
#define MFMA16(a, b, c) __builtin_amdgcn_mfma_f32_16x16x32_bf16((a), (b), (c), 0, 0, 0)
#define LDS_WAIT() asm volatile("s_waitcnt lgkmcnt(0)" ::: "memory")

#define XB_TMO      128
#define XB_XCNT(j)  (256  + 64 * (j))
#define XB_XSUB(j)  (1280 + 64 * (j))
#define XB_XGEN(j)  (2304 + 64 * (j))
#define XB_TOP      3328
#define XB_TOPGEN   3392
#define XCD_BAR_WORDS 3456
#define XB_SPIN_CAP (1u << 18)

__device__ __forceinline__ unsigned xb_ld(unsigned* p)              { return __hip_atomic_load(p, __ATOMIC_RELAXED, __HIP_MEMORY_SCOPE_AGENT); }
__device__ __forceinline__ unsigned xb_add(unsigned* p, unsigned v) { return __hip_atomic_fetch_add(p, v, __ATOMIC_RELAXED, __HIP_MEMORY_SCOPE_AGENT); }
__device__ __forceinline__ unsigned xb_xcc_id() { return (unsigned)__builtin_amdgcn_s_getreg((3 << 11) | 20) & 0xFu; }
#define XB_SPIN(cond, bar) do { unsigned _sp = 0; while (cond) { __builtin_amdgcn_s_sleep(1); \
    if ((++_sp & 255u) == 0u) { if (xb_ld(&(bar)[XB_TMO])) break; if (_sp > XB_SPIN_CAP) { atomicAdd(&(bar)[XB_TMO], 1u); break; } } } } while (0)

struct XcdBarrier {
    unsigned* bar; unsigned x;
    volatile LAS unsigned* st;
};

__device__ __forceinline__ XcdBarrier xcd_barrier_post(unsigned* bar, volatile LAS unsigned* st) {
    XcdBarrier b; b.bar = bar; b.x = xb_xcc_id(); b.st = st;
    if (threadIdx.x == 0) (void)xb_add(&bar[XB_XCNT(b.x)], 1u);
    return b;
}
__device__ __forceinline__ void xcd_barrier_complete(unsigned* bar, unsigned x, unsigned& nloc, unsigned& nx) {
    const unsigned G = gridDim.x * gridDim.y * gridDim.z;
    unsigned sum, cnt, mine, sp = 0u;
    for (;;) {
        sum = 0u; cnt = 0u; mine = 0u;
#pragma unroll
        for (unsigned j = 0; j < 16; ++j) { const unsigned c = xb_ld(&bar[XB_XCNT(j)]); sum += c; cnt += (c > 0u) ? 1u : 0u; mine = (j == x) ? c : mine; }
        if (sum == G) break;
        __builtin_amdgcn_s_sleep(1);
        if ((++sp & 255u) == 0u) { if (xb_ld(&bar[XB_TMO])) break; if (sp > XB_SPIN_CAP) { atomicAdd(&bar[XB_TMO], 1u); break; } }
    }
    nloc = mine > 0u ? mine : 1u; nx = cnt > 0u ? cnt : 1u;
}

__device__ __forceinline__ void xcd_barrier(const XcdBarrier& b) {
    asm volatile("s_waitcnt vmcnt(0)" ::: "memory");
    __syncthreads();
    if (threadIdx.x == 0) {
        unsigned* bar = b.bar;
        __builtin_amdgcn_s_waitcnt(0);
        unsigned nloc = b.st[0], nx = b.st[1];
        if (nloc == 0u) { xcd_barrier_complete(bar, b.x, nloc, nx); b.st[0] = nloc; b.st[1] = nx; }
        const unsigned old = xb_add(&bar[XB_XSUB(b.x)], 1u);
        const unsigned gen = old / nloc;
        if (old + 1u == (gen + 1u) * nloc) {
            __builtin_amdgcn_fence(__ATOMIC_RELEASE, "agent");
            asm volatile("s_waitcnt vmcnt(0)" ::: "memory");
            const unsigned og = xb_add(&bar[XB_TOP], 1u);
            const unsigned tg = og / nx;
            if (og + 1u == (tg + 1u) * nx) xb_add(&bar[XB_TOPGEN], 1u);
            else XB_SPIN(xb_ld(&bar[XB_TOPGEN]) == tg, bar);
            __builtin_amdgcn_fence(__ATOMIC_ACQUIRE, "agent");
            xb_add(&bar[XB_XGEN(b.x)], 1u);
            asm volatile("s_waitcnt vmcnt(0)" ::: "memory");
        } else {
            XB_SPIN(xb_ld(&bar[XB_XGEN(b.x)]) == gen, bar);
            __builtin_amdgcn_fence(__ATOMIC_ACQUIRE, "agent");
            asm volatile("s_waitcnt vmcnt(0)" ::: "memory");
        }
    }
    __syncthreads();
}

__device__ __forceinline__ void transpose_item(const float* W, int ldw, int k0, int n0, bf16* WT, int ldt, int drow0, int dk0, LAS float* scr, int lane) {
    float tv[32];
#pragma unroll
    for (int i = 0; i < 32; ++i) tv[i] = __builtin_nontemporal_load(W + (size_t)(k0 + 2 * i + (lane >> 5)) * ldw + n0 + (lane & 31));
#pragma unroll
    for (int i = 0; i < 32; ++i) scr[(2 * i + (lane >> 5)) * 33 + (lane & 31)] = tv[i];
    LDS_WAIT(); asm volatile("" ::: "memory");
    const int c = lane & 7;
#pragma unroll
    for (int j = 0; j < 4; ++j) { const int n = (lane >> 3) + 8 * j; const LAS float* s = scr + (8 * c) * 33 + n;
        v4u o; o.x = pk2(s[0 * 33], s[1 * 33]); o.y = pk2(s[2 * 33], s[3 * 33]); o.z = pk2(s[4 * 33], s[5 * 33]); o.w = pk2(s[6 * 33], s[7 * 33]);
        *(v4u*)(WT + (size_t)(drow0 + n) * ldt + dk0 + 8 * c) = o; }
    LDS_WAIT(); asm volatile("" ::: "memory");
}

__device__ __forceinline__ void phase0(const Params& p, LAS unsigned char* lds) {
    const int tid = threadIdx.x, lane = tid & 63, wave = tid >> 6, bid = blockIdx.x, G = gridDim.x;
    unsigned char* ws = p.ws;
    float* MODP = (float*)(ws + WS_MODP);
    for (int item = bid; item < 192; item += G) {
        const int cg = item >> 1, ks = item & 1;
        LAS float* s = (LAS float*)lds;
        for (int i = tid; i < 1536; i += NTHR) { const int v = i >> 9, k = ks * 512 + (i & 511); const float x = v < 2 ? p.c[v * 1024 + k] : p.c_ctx[k]; s[i] = siluf_(x); }
        __syncthreads();
        const int cc = tid & 31, kq = tid >> 5, col = cg * 32 + cc;
        float a0 = 0.f, a1 = 0.f, a2 = 0.f;
        const float* wp = p.w_mod + (size_t)(ks * 512 + kq) * 3072 + col;
        float wv[32];
#pragma unroll
        for (int i = 0; i < 32; ++i) wv[i] = wp[(size_t)i * 16 * 3072];
#pragma unroll
        for (int i = 0; i < 32; ++i) { const float w = wv[i]; const int k = kq + 16 * i; a0 += s[k] * w; a1 += s[512 + k] * w; a2 += s[1024 + k] * w; }
        LAS float* red = s + 1536;
        red[(kq * 32 + cc) * 3 + 0] = a0; red[(kq * 32 + cc) * 3 + 1] = a1; red[(kq * 32 + cc) * 3 + 2] = a2;
        __syncthreads();
        if (tid < 96) { const int c2 = tid & 31, v = tid >> 5; float sum = 0.f;
            for (int q = 0; q < 16; ++q) sum += red[(q * 32 + c2) * 3 + v];
            const int colg = cg * 32 + c2; if (ks == 0) sum += p.b_mod[colg];
            MODP[(ks * 3 + v) * 3072 + colg] = sum; }
        __syncthreads();
    }
    LAS float* scr = (LAS float*)(lds + 16384 + wave * 8704);
    const int gw = bid * 8 + wave, NGW = G * 8;
    bf16* WIT = (bf16*)(ws + WS_WIT); bf16* WLR = (bf16*)(ws + WS_WLR); bf16* W2T = (bf16*)(ws + WS_W2T); bf16* WOT = (bf16*)(ws + WS_WOT); bf16* WSB = (bf16*)(ws + WS_WSB);
    constexpr int I_IN = 16 * 161, I_A = 8 * 32, I_B = 8 * 32, I_O = 16 * 32;
    for (int it = gw; it < I_IN + I_A + I_B + I_O; it += NGW) {
        int r = it;
        if (r < I_IN) { const int kb = r / 161, nb = r % 161;
            if (nb == 32) transpose_item(p.w_in, INW, 64 * kb, 32 * nb, WLR, 1024, 0, 64 * kb, scr, lane);
            else { const int oc = 32 * (nb < 32 ? nb : nb - 1); int crow = oc;
                if (oc >= CG) { const int gi = oc - CG, c = gi & 1023; crow = CG + (c >> 7) * 256 + (gi >> 10) * 128 + (c & 127); }
                else if (oc >= CUA && oc < CVA) { const int c = oc - CUA, T = c >> 7; crow = (T < 2 ? CUA + T * 256 : CZA + (T - 2) * 256) + (c & 127); }
                else if (oc >= CZA && oc < CG) { const int c = oc - CZA, T = c >> 7; crow = (T < 2 ? CUA + T * 256 : CZA + (T - 2) * 256) + 128 + (c & 127); }
                transpose_item(p.w_in, INW, 64 * kb, 32 * nb, WIT, 1024, crow, 64 * kb, scr, lane); }
            continue; } r -= I_IN;
        if (r < I_A) { const int kb = r / 32, nb = r % 32; transpose_item(p.wpa, 1024, 64 * kb, 32 * nb, W2T, 1024, 32 * nb, 64 * kb, scr, lane); continue; } r -= I_A;
        if (r < I_B) { const int kb = r / 32, nb = r % 32; transpose_item(p.wpb, 1024, 64 * kb, 32 * nb, W2T, 1024, 32 * nb, 512 + 64 * kb, scr, lane); continue; } r -= I_B;
        { const int kb = r / 32, nb = r % 32; transpose_item(p.w_out, 1024, 64 * kb, 32 * nb, WOT, 1024, 32 * nb, 64 * kb, scr, lane); }
    }
    for (int i = bid * NTHR + tid; i < 32768; i += G * NTHR) { const f32x2 v = ((const f32x2*)p.a_ws)[i]; ((unsigned*)WSB)[i] = pk2(v.x, v.y); }
}

constexpr int HP = 2064;
__device__ __forceinline__ void phase1(const Params& p, LAS unsigned char* lds) {
    const int tid = threadIdx.x, lane = tid & 63, wave = tid >> 6, fr = lane & 15, fq = lane >> 4;
    unsigned char* ws = p.ws;
    const float* MODP = (const float*)(ws + WS_MODP);
    bf16* H = (bf16*)((unsigned char*)p.out + OUT_H);
    const bf16* WIT = (const bf16*)(ws + WS_WIT); const bf16* WLR = (const bf16*)(ws + WS_WLR);
    float* LR = (float*)(ws + WS_LR); float* LRC = (float*)(ws + WS_LRC); bf16* PCKV = (bf16*)(ws + WS_PCKV);
    for (int item = blockIdx.x; item < 480; item += gridDim.x) {
        const bool isctx = item >= 256;
        int rt = item, cgp = 0; if (isctx) { rt = (item - 256) / 7; cgp = (item - 256) % 7; }
        const int nrow = isctx ? 16 : 64, rpw = nrow >> 3;
        const float* xin = isctx ? p.ctx + (size_t)rt * 16 * 1024 : p.x + (size_t)rt * 64 * 1024;
        const int v = isctx ? 2 : (rt >> 7);
        const float* sh0 = MODP + v * 3072, *sh1 = MODP + (3 + v) * 3072;
        f32x4 gs[4], sh[4];
#pragma unroll
        for (int j = 0; j < 4; ++j) { const int ci = lane + 64 * j; const f32x4 g4 = ((const f32x4*)p.norm_g)[ci], s4 = ((const f32x4*)(sh0 + 1024))[ci] + ((const f32x4*)(sh1 + 1024))[ci];
            gs[j] = g4 * (1.0f + s4); sh[j] = ((const f32x4*)sh0)[ci] + ((const f32x4*)sh1)[ci]; }
        for (int i0 = 0; i0 < rpw; i0 += 4) {
            f32x4 xv[4][4]; const int nr = rpw - i0 < 4 ? rpw - i0 : 4;
#pragma unroll
            for (int q = 0; q < 4; ++q) if (q < nr) { const f32x4* xr = (const f32x4*)(xin + (size_t)(wave * rpw + i0 + q) * 1024);
#pragma unroll
                for (int j = 0; j < 4; ++j) xv[q][j] = __builtin_nontemporal_load(xr + lane + 64 * j); }
#pragma unroll
            for (int q = 0; q < 4; ++q) if (q < nr) { const int r = wave * rpw + i0 + q; float ss = 0.f;
#pragma unroll
                for (int j = 0; j < 4; ++j) ss += (xv[q][j].x * xv[q][j].x + xv[q][j].y * xv[q][j].y) + (xv[q][j].z * xv[q][j].z + xv[q][j].w * xv[q][j].w);
                const float rs = rsqrtf(wave_sum(ss) * (1.0f / 1024.0f) + EPS);
#pragma unroll
                for (int j = 0; j < 4; ++j) { const int col = 4 * lane + 256 * j; const f32x4 hv = xv[q][j] * rs * gs[j] + sh[j];
                    v2u o; o.x = pk2(hv.x, hv.y); o.y = pk2(hv.z, hv.w);
                    *(LAS v2u*)(lds + r * HP + col * 2) = o;
                    if (!isctx) *(v2u*)(H + (size_t)(rt * 64 + r) * 1024 + col) = o; } }
        }
        __syncthreads();
        {
            int tt, n; bool active = true;
            if (!isctx) { tt = wave >> 1; n = 768 + (wave & 1) * 16; }
            else if (cgp < 6) { tt = 0; n = cgp * 128 + wave * 16; }
            else { tt = 0; n = 768 + (wave & 1) * 16; active = wave < 2; }
            if (active) {
                const LAS unsigned char* ap = lds + (tt * 16 + fr) * HP + fq * 16;
                const bf16* bp = (n < 768 ? WIT + (size_t)(256 + n + fr) * 1024 : WLR + (size_t)(n - 768 + fr) * 1024) + fq * 8;
                f32x4 acc0 = {0.f, 0.f, 0.f, 0.f}, acc1 = {0.f, 0.f, 0.f, 0.f};
#pragma unroll
                for (int kk = 0; kk < 32; kk += 2) { const bf16x8 a0 = *(const LAS bf16x8*)(ap + kk * 64), a1 = *(const LAS bf16x8*)(ap + kk * 64 + 64);
                    const bf16x8 b0 = *(const bf16x8*)(bp + kk * 32), b1 = *(const bf16x8*)(bp + kk * 32 + 32); acc0 = MFMA16(a0, b0, acc0); acc1 = MFMA16(a1, b1, acc1); }
                const f32x4 acc = acc0 + acc1;
#pragma unroll
                for (int j = 0; j < 4; ++j) { const int rl = tt * 16 + fq * 4 + j;
                    if (!isctx) LR[(size_t)(rt * 64 + rl) * 32 + (n - 768) + fr] = acc[j];
                    else if (n < 768) PCKV[(size_t)(rt * 16 + rl) * 768 + n + fr] = (bf16)(pk2(acc[j], 0.f) & 0xffffu);
                    else LRC[(size_t)(rt * 16 + rl) * 32 + (n - 768) + fr] = acc[j]; }
            }
        }
        __syncthreads();
    }
}

typedef const __attribute__((address_space(4))) float cfloat_t;
typedef const __attribute__((address_space(4))) f32x4 cf32x4_t;
__device__ __forceinline__ cfloat_t* uniform_const_ptr(const float* p) {
    const unsigned long long a = (unsigned long long)p;
    unsigned lo = __builtin_amdgcn_readfirstlane((unsigned)a), hi = __builtin_amdgcn_readfirstlane((unsigned)(a >> 32));
    asm volatile("" : "+s"(lo), "+s"(hi));
    return (cfloat_t*)(((unsigned long long)hi << 32) | (unsigned long long)lo);
}
#define GLA_LA(la, lrs, dir, dkt, W2, GB) do { \
    float w2c[16]; _Pragma("unroll") for (int r_ = 0; r_ < 16; ++r_) w2c[r_] = (W2)[((dir) * 16 + r_) * 256 + (dkt)]; \
    const float gbv_ = (GB)[(dir) * 256 + (dkt)]; \
    _Pragma("unroll") for (int t_ = 0; t_ < 64; ++t_) { \
        const LAS f32x4* l4_ = (const LAS f32x4*)((lrs) + t_ * 32 + (dir) * 16); float lg_ = gbv_; \
        _Pragma("unroll") for (int r4_ = 0; r4_ < 4; ++r4_) { const f32x4 x_ = l4_[r4_]; lg_ += x_.x * w2c[4 * r4_] + x_.y * w2c[4 * r4_ + 1] + x_.z * w2c[4 * r4_ + 2] + x_.w * w2c[4 * r4_ + 3]; } \
        la[t_] = logsigf_(lg_) * 0.0625f; } } while (0)

constexpr int TP = 72;
__device__ __forceinline__ void stage_vT(const bf16* vptr, int pitch, LAS bf16* vT, int tid) {
    const bf16* src = vptr + tid;
    unsigned r[64];
#pragma unroll
    for (int t = 0; t < 64; ++t) r[t] = src[(size_t)t * pitch];
#pragma unroll
    for (int j = 0; j < 8; ++j) { v4u o; o.x = r[8 * j] | (r[8 * j + 1] << 16); o.y = r[8 * j + 2] | (r[8 * j + 3] << 16); o.z = r[8 * j + 4] | (r[8 * j + 5] << 16); o.w = r[8 * j + 6] | (r[8 * j + 7] << 16);
        *(LAS v4u*)(vT + tid * TP + 8 * j) = o; }
}

__device__ __forceinline__ void gate_tile(const float* lrp, const float* gw2, const float* gb, int d, int c0, int crow0, LAS bf16* laT, int fr, int fq) {
    bf16x8 Bw = {0, 0, 0, 0, 0, 0, 0, 0};
    if ((fq >> 1) == d) { const float* wp = gw2 + (size_t)(d * 16 + (fq & 1) * 8) * 256 + c0 + fr; float w[8];
#pragma unroll
        for (int e = 0; e < 8; ++e) w[e] = wp[e * 256];
        v4u t; t.x = pk2(w[0], w[1]); t.y = pk2(w[2], w[3]); t.z = pk2(w[4], w[5]); t.w = pk2(w[6], w[7]); Bw = __builtin_bit_cast(bf16x8, t); }
    const float gbv = gb[d * 256 + c0 + fr];
#pragma unroll
    for (int tt = 0; tt < 4; ++tt) {
        const f32x4 a0 = *(const f32x4*)(lrp + (size_t)(tt * 16 + fr) * 32 + fq * 8), a1 = *(const f32x4*)(lrp + (size_t)(tt * 16 + fr) * 32 + fq * 8 + 4);
        v4u t; t.x = pk2(a0.x, a0.y); t.y = pk2(a0.z, a0.w); t.z = pk2(a1.x, a1.y); t.w = pk2(a1.z, a1.w);
        f32x4 acc = {0.f, 0.f, 0.f, 0.f}; acc = MFMA16(__builtin_bit_cast(bf16x8, t), Bw, acc);
        v2u o; o.x = pk2(logsigf_(acc[0] + gbv) * 0.0625f, logsigf_(acc[1] + gbv) * 0.0625f); o.y = pk2(logsigf_(acc[2] + gbv) * 0.0625f, logsigf_(acc[3] + gbv) * 0.0625f);
        *(LAS v2u*)(laT + (crow0 + fr) * TP + tt * 16 + fq * 4) = o; }
}

template <int NC> __device__ __forceinline__ void stage_nat(const bf16* src, int pitch, LAS unsigned char* X, int LPB, int tid) {
    constexpr int PPR = NC / 8, NPT = 64 * PPR / 512;
#pragma unroll
    for (int i = 0; i < NPT; ++i) { const int id = tid + 512 * i, row = id / PPR, pc = id % PPR;
        *(LAS v4u*)(X + row * LPB + pc * 16) = *(const v4u*)(src + (size_t)row * pitch + pc * 8); }
}
__device__ __forceinline__ void col_to_row(const LAS unsigned char* X, int LPB, int c, LAS bf16* dst) {
    unsigned r[64];
#pragma unroll
    for (int t = 0; t < 64; ++t) r[t] = *(const LAS bf16*)(X + t * LPB + c * 2);
#pragma unroll
    for (int j = 0; j < 8; ++j) { v4u o; o.x = r[8 * j] | (r[8 * j + 1] << 16); o.y = r[8 * j + 2] | (r[8 * j + 3] << 16); o.z = r[8 * j + 4] | (r[8 * j + 5] << 16); o.w = r[8 * j + 6] | (r[8 * j + 7] << 16);
        *(LAS v4u*)(dst + 8 * j) = o; }
}

template <int MODE> __device__ __forceinline__ void phase3a(const Params& p, LAS unsigned char* lds, bool do_ln) {
    const int tid = threadIdx.x, lane = tid & 63, wave = tid >> 6, fr = lane & 15, fq = lane >> 4;
    unsigned char* ws = p.ws;
    bf16* P = (bf16*)(ws + WS_P); const bf16* PCKV = (const bf16*)(ws + WS_PCKV);
    const float* LR = (const float*)(ws + WS_LR); const float* LRC = (const float*)(ws + WS_LRC);
    bf16* KV = (bf16*)(ws + (MODE ? 214 * MiB : WS_KV)); float* DEC = (float*)(ws + (MODE ? 250 * MiB : WS_DEC)); float* TOT = (float*)(ws + (MODE ? 252 * MiB : WS_TOT));
    LAS float* lrs = (LAS float*)lds; LAS bf16* kT = (LAS bf16*)(lds + 8192); LAS bf16* vT = (LAS bf16*)(lds + 8192 + 73728);
    for (int item = blockIdx.x; item < 256; item += gridDim.x) {
        const bf16 *kptr, *vptr; const float* lrp; int pitch, slot, b;
        if (item < 256) { b = item >> 7; const int n = item & 127; const size_t row0 = (size_t)b * SEQ + n * 64; kptr = P + row0 * NP + CK; vptr = P + row0 * NP + CV; pitch = NP; lrp = LR + row0 * 32; slot = 4 + n; }
        else { const int cc = item - 256; b = cc >> 2; const int n = cc & 3; const size_t row0 = (size_t)b * 256 + n * 64; kptr = PCKV + row0 * 768; vptr = kptr + 256; pitch = 768; lrp = LRC + row0 * 32; slot = n; }
        int tl = tid; asm volatile("" : "+v"(tl));
        LAS unsigned char* X = (LAS unsigned char*)kT;
        stage_nat<512>(vptr, pitch, X, 1040, tl);
        __syncthreads();
        col_to_row(X, 1040, tl, vT + tl * TP);
        __syncthreads();
        stage_nat<256>(kptr, pitch, X, 528, tl);
        __syncthreads();
        {
            const int dir = tl >> 8, dkt = tl & 255;
            unsigned kraw[64];
#pragma unroll
            for (int t = 0; t < 64; ++t) kraw[t] = *(const LAS bf16*)(X + t * 528 + dkt * 2);
            __syncthreads();
            float la[64];
            {
                const int fr2 = tl & 15, fq2 = (tl >> 4) & 3, wv = __builtin_amdgcn_readfirstlane(tl >> 6);
#pragma unroll
                for (int j = 0; j < 4; ++j) { const int c = (wv * 4 + j) * 16; gate_tile(lrp, p.gw2, p.gb, c >> 8, c & 255, c, kT, fr2, fq2); }
                __syncthreads();
#pragma unroll
                for (int j = 0; j < 8; ++j) { const v4u r = *(const LAS v4u*)(kT + tl * TP + 8 * j);
                    la[8 * j] = bflo(r.x); la[8 * j + 1] = bfhi(r.x); la[8 * j + 2] = bflo(r.y); la[8 * j + 3] = bfhi(r.y); la[8 * j + 4] = bflo(r.z); la[8 * j + 5] = bfhi(r.z); la[8 * j + 6] = bflo(r.w); la[8 * j + 7] = bfhi(r.w); }
                __syncthreads();
            }
            float run = 0.f;
#pragma unroll
            for (int t = 0; t < 64; ++t) { const float l = la[t]; run += l; la[t] = dir ? (run - l) : run; }
            const float total = run;
            DEC[(size_t)(dir * 2 * NSLOT + b * NSLOT + slot) * 256 + dkt] = __expf(total);
            if (dir && item < 256) TOT[(size_t)item * 256 + dkt] = total;
            unsigned w[32];
#pragma unroll
            for (int t = 0; t < 32; ++t) {
                const float e0 = dir ? la[2 * t] : total - la[2 * t], e1 = dir ? la[2 * t + 1] : total - la[2 * t + 1];
                const float k0 = __builtin_bit_cast(float, kraw[2 * t] << 16), k1 = __builtin_bit_cast(float, kraw[2 * t + 1] << 16);
#if defined(P3A_KONLY)
                w[t] = pk2(k0, k1); }
#elif defined(P3A_SYNTH)
                w[t] = pk2((float)((tid * 7 + t * 3) & 63) * 0.125f, (float)((tid * 5 + t) & 31) * 0.25f); }
#elif defined(P3A_EONLY)
                w[t] = pk2(__expf(e0), __expf(e1)); }
#else
                w[t] = pk2(k0 * __expf(e0), k1 * __expf(e1)); }
#endif
#pragma unroll
            for (int j = 0; j < 8; ++j) { v4u o; o.x = w[4 * j]; o.y = w[4 * j + 1]; o.z = w[4 * j + 2]; o.w = w[4 * j + 3]; *(LAS v4u*)(kT + tl * TP + 8 * j) = o; }
        }
        __syncthreads();
        if (MODE != 3) {
            const int dir = wave >> 2, h = wave & 3;
            bf16* kvo = KV + ((size_t)(dir * 2 * NSLOT + b * NSLOT + slot) * 4 + h) * 8192;
            bf16x8 A[4][2];
#pragma unroll
            for (int mi = 0; mi < 4; ++mi)
#pragma unroll
                for (int kk = 0; kk < 2; ++kk) A[mi][kk] = *(const LAS bf16x8*)(kT + (dir * 256 + h * 64 + mi * 16 + fr) * TP + kk * 32 + fq * 8);
#ifdef P3A_CONST_K
#pragma unroll
            for (int mi = 0; mi < 4; ++mi) { A[mi][0] = (bf16x8){0x3f80, 0x3f80, 0x3f80, 0x3f80, 0x3f80, 0x3f80, 0x3f80, 0x3f80}; A[mi][1] = A[mi][0]; }
#endif
            f32x4 acc[8][4];
#pragma unroll
            for (int ni = 0; ni < 8; ++ni) {
                bf16x8 B[2];
#pragma unroll
                for (int kk = 0; kk < 2; ++kk) B[kk] = *(const LAS bf16x8*)(vT + (h * 128 + ni * 16 + fr) * TP + kk * 32 + fq * 8);
#pragma unroll
                for (int mi = 0; mi < 4; ++mi) { f32x4 c = {0.f, 0.f, 0.f, 0.f}; c = MFMA16(A[mi][0], B[0], c); acc[ni][mi] = MFMA16(A[mi][1], B[1], c); }
            }
            __syncthreads();
            LAS bf16* sl = kT + wave * (128 * TP);
#pragma unroll
            for (int ni = 0; ni < 8; ++ni)
#pragma unroll
                for (int mi = 0; mi < 4; ++mi) { v2u o; o.x = pk2(acc[ni][mi][0], acc[ni][mi][1]); o.y = pk2(acc[ni][mi][2], acc[ni][mi][3]);
                    *(LAS v2u*)(sl + (ni * 16 + fr) * TP + mi * 16 + fq * 4) = o; }
            LDS_WAIT(); asm volatile("" ::: "memory");
#pragma unroll
            for (int i = 0; i < 16; ++i) { const int id = lane + 64 * i, row = id >> 3, part = id & 7;
                *(v4u*)(kvo + (size_t)row * 64 + part * 8) = *(const LAS v4u*)(sl + row * TP + part * 8); }
        }
        __syncthreads();
    }
    for (int sub = blockIdx.x; sub < 64; sub += gridDim.x) {
        const int cc = sub >> 3, dir = (sub >> 2) & 1, h = sub & 3, b = cc >> 2, slot = cc & 3;
        const size_t row0 = (size_t)b * 256 + slot * 64;
        const bf16* kptr = PCKV + row0 * 768; const bf16* vptr = kptr + 256; const float* lrp = LRC + row0 * 32;
        int tl = tid; asm volatile("" : "+v"(tl));
        const int wv = __builtin_amdgcn_readfirstlane(tl >> 6), fr2 = tl & 15, fq2 = (tl >> 4) & 3;
        { const int ch = tl & 127, tq = tl >> 7; const bf16* src = vptr + (size_t)(tq * 16) * 768 + h * 128 + ch; unsigned r[16];
#pragma unroll
          for (int t = 0; t < 16; ++t) r[t] = src[(size_t)t * 768];
#pragma unroll
          for (int j = 0; j < 2; ++j) { v4u o; o.x = r[8 * j] | (r[8 * j + 1] << 16); o.y = r[8 * j + 2] | (r[8 * j + 3] << 16); o.z = r[8 * j + 4] | (r[8 * j + 5] << 16); o.w = r[8 * j + 6] | (r[8 * j + 7] << 16);
              *(LAS v4u*)(vT + (h * 128 + ch) * TP + tq * 16 + 8 * j) = o; } }
        if (wv < 4) { const int c0 = h * 64 + wv * 16; gate_tile(lrp, p.gw2, p.gb, dir, c0, dir * 256 + c0, kT, fr2, fq2); }
        __syncthreads();
        if (wv == 0) {
            const int dkt = h * 64 + tl, crow = dir * 256 + dkt;
            unsigned kraw[64];
#pragma unroll
            for (int t = 0; t < 64; ++t) kraw[t] = kptr[(size_t)t * 768 + dkt];
            float la[64];
#pragma unroll
            for (int j = 0; j < 8; ++j) { const v4u r = *(const LAS v4u*)(kT + crow * TP + 8 * j);
                la[8 * j] = bflo(r.x); la[8 * j + 1] = bfhi(r.x); la[8 * j + 2] = bflo(r.y); la[8 * j + 3] = bfhi(r.y); la[8 * j + 4] = bflo(r.z); la[8 * j + 5] = bfhi(r.z); la[8 * j + 6] = bflo(r.w); la[8 * j + 7] = bfhi(r.w); }
            float run = 0.f;
#pragma unroll
            for (int t = 0; t < 64; ++t) { const float l = la[t]; run += l; la[t] = dir ? (run - l) : run; }
            const float total = run;
            DEC[(size_t)(dir * 2 * NSLOT + b * NSLOT + slot) * 256 + dkt] = __expf(total);
            unsigned w[32];
#pragma unroll
            for (int t = 0; t < 32; ++t) {
                const float e0 = dir ? la[2 * t] : total - la[2 * t], e1 = dir ? la[2 * t + 1] : total - la[2 * t + 1];
                w[t] = pk2(__builtin_bit_cast(float, kraw[2 * t] << 16) * __expf(e0), __builtin_bit_cast(float, kraw[2 * t + 1] << 16) * __expf(e1)); }
#pragma unroll
            for (int j = 0; j < 8; ++j) { v4u o; o.x = w[4 * j]; o.y = w[4 * j + 1]; o.z = w[4 * j + 2]; o.w = w[4 * j + 3]; *(LAS v4u*)(kT + crow * TP + 8 * j) = o; }
        }
        __syncthreads();
        {
            bf16* kvo = KV + ((size_t)(dir * 2 * NSLOT + b * NSLOT + slot) * 4 + h) * 8192;
            bf16x8 B[2]; f32x4 acc[4];
#pragma unroll
            for (int kk = 0; kk < 2; ++kk) B[kk] = *(const LAS bf16x8*)(vT + (h * 128 + wv * 16 + fr2) * TP + kk * 32 + fq2 * 8);
#pragma unroll
            for (int mi = 0; mi < 4; ++mi) { const LAS bf16* ar = kT + (dir * 256 + h * 64 + mi * 16 + fr2) * TP + fq2 * 8;
                f32x4 c = {0.f, 0.f, 0.f, 0.f}; c = MFMA16(*(const LAS bf16x8*)ar, B[0], c); acc[mi] = MFMA16(*(const LAS bf16x8*)(ar + 32), B[1], c); }
            __syncthreads();
            LAS bf16* sl = kT + wv * (16 * TP);
#pragma unroll
            for (int mi = 0; mi < 4; ++mi) { v2u o; o.x = pk2(acc[mi][0], acc[mi][1]); o.y = pk2(acc[mi][2], acc[mi][3]); *(LAS v2u*)(sl + fr2 * TP + mi * 16 + fq2 * 4) = o; }
            LDS_WAIT(); asm volatile("" ::: "memory");
#pragma unroll
            for (int i = 0; i < 2; ++i) { const int id = (tl & 63) + 64 * i, row = id >> 3, part = id & 7;
                *(v4u*)(kvo + (size_t)(wv * 16 + row) * 64 + part * 8) = *(const LAS v4u*)(sl + row * TP + part * 8); }
        }
        __syncthreads();
    }
    if (do_ln) {
        const int nskip = (int)gridDim.x > 128 ? 64 : 0;
        const int gw = ((int)blockIdx.x - nskip) * 8 + wave, NGW = ((int)gridDim.x - nskip) * 8;
        float g[8], bb[8];
#pragma unroll
        for (int i = 0; i < 8; ++i) { g[i] = p.a_ln_g[lane * 8 + i]; bb[i] = p.a_ln_b[lane * 8 + i]; }
        if (gw >= 0) for (int row = gw; row < M; row += NGW) {
            v4u* pp = (v4u*)(P + (size_t)row * NP + CVA) + lane; const v4u raw = *pp;
            float v[8] = {bflo(raw.x), bfhi(raw.x), bflo(raw.y), bfhi(raw.y), bflo(raw.z), bfhi(raw.z), bflo(raw.w), bfhi(raw.w)};
            float s = 0.f;
#pragma unroll
            for (int i = 0; i < 8; ++i) s += v[i];
            const float mean = wave_sum(s) * (1.0f / 512.0f); float s2 = 0.f;
#pragma unroll
            for (int i = 0; i < 8; ++i) { v[i] -= mean; s2 += v[i] * v[i]; }
            const float rstd = rsqrtf(wave_sum(s2) * (1.0f / 512.0f) + EPS);
#pragma unroll
            for (int i = 0; i < 8; ++i) v[i] = v[i] * rstd * g[i] + bb[i];
            v4u o; o.x = pk2(v[0], v[1]); o.y = pk2(v[2], v[3]); o.z = pk2(v[4], v[5]); o.w = pk2(v[6], v[7]); *pp = o;
        }
    }
}

__device__ __forceinline__ void phase3b(const Params& p) {
    unsigned char* ws = p.ws;
    const bf16* KV = (const bf16*)(ws + WS_KV); const float* DEC = (const float*)(ws + WS_DEC);
    bf16* SB = (bf16*)((unsigned char*)p.out + OUT_SB);
    for (int e = blockIdx.x * NTHR + threadIdx.x; e < 131072; e += gridDim.x * NTHR) {
        const int dk = e & 63, dv = (e >> 6) & 127, h = (e >> 13) & 3, b = (e >> 15) & 1, dir = e >> 16;
        const size_t kvb = ((size_t)(dir * 2 * NSLOT + b * NSLOT) * 4 + h) * 8192 + dv * 64 + dk;
        const size_t dcb = (size_t)(dir * 2 * NSLOT + b * NSLOT) * 256 + h * 64 + dk;
        const size_t sbb = ((size_t)((dir * 2 + b) * 128) * 4 + h) * 8192 + dv * 64 + dk;
        float s0 = 0.f;
        for (int u0 = 0; u0 < 132; u0 += 12) {
            bf16 kvv[12]; float dc[12];
#pragma unroll
            for (int j = 0; j < 12; ++j) { const int u = u0 + j, slot = dir ? (u < 4 ? 3 - u : 135 - u) : u;
                kvv[j] = KV[kvb + (size_t)slot * 32768]; dc[j] = DEC[dcb + (size_t)slot * 256]; }
#pragma unroll
            for (int j = 0; j < 12; ++j) { const int u = u0 + j, slot = dir ? (u < 4 ? 3 - u : 135 - u) : u;
                if (u >= 4) SB[sbb + (size_t)(slot - 4) * 32768] = (bf16)(pk2(s0, 0.f) & 0xffffu);
                s0 = dc[j] * s0 + bf1(kvv[j]); }
        }
    }
}

constexpr int QP = 264;
template <int MODE> __device__ __forceinline__ void phase3c(const Params& p, LAS unsigned char* lds) {
    const int tid = threadIdx.x, lane = tid & 63, wave = tid >> 6, fr = lane & 15, fq = lane >> 4;
    unsigned char* ws = p.ws;
    const bf16* P = (const bf16*)(ws + WS_P); const float* LR = (const float*)(ws + WS_LR);
    const bf16* SB = (const bf16*)((unsigned char*)p.out + OUT_SB); bf16* A2 = MODE ? (bf16*)(ws + 214 * MiB) : (bf16*)((unsigned char*)p.out + OUT_H);
    const bf16* WSB = (const bf16*)(ws + WS_WSB); const float* TOT = (const float*)(ws + WS_TOT);
    LAS float* lrs = (LAS float*)lds; LAS bf16* qd = (LAS bf16*)(lds + 8192); LAS bf16* kd = (LAS bf16*)(lds + 8192 + 33792); LAS bf16* vT = (LAS bf16*)(lds + 8192 + 2 * 33792);
    for (int item = blockIdx.x; item < 256; item += gridDim.x) {
        const int b = item >> 7, n = item & 127; const size_t row0 = (size_t)b * SEQ + n * 64;
        const bf16* prow = P + row0 * NP;
        LAS unsigned char* X = (LAS unsigned char*)qd;
        if (MODE != 5) { int ts = tid; asm volatile("" : "+v"(ts));
          stage_nat<512>(prow + CV, NP, X, 1040, ts);
          __syncthreads();
          col_to_row(X, 1040, ts, vT + ts * TP); }
        const int h = wave >> 1, th = wave & 1;
        f32x4 oacc[8][2];
#pragma unroll
        for (int a = 0; a < 8; ++a)
#pragma unroll
            for (int c = 0; c < 2; ++c) oacc[a][c] = (f32x4){0.f, 0.f, 0.f, 0.f};
#pragma unroll 1
        for (int dir = 0; dir < 2; ++dir) {
            __syncthreads();
            int tl = tid; asm volatile("" : "+v"(tl));
            const int fr = tl & 15, fq = (tl >> 4) & 3;
            if (MODE != 2) {
                const int role = tl >> 8, dkt = tl & 255;
                const float total = dir ? TOT[(size_t)(b * 128 + n) * 256 + dkt] : 0.f;
                const bf16* src = prow + (role ? CK : CQ) + dkt; LAS bf16* dst = (role ? kd : qd) + dkt;
                const float sgn = role ? -1.0f : 1.0f, mul = role ? 1.0f : 0.125f;
                stage_nat<512>(prow + CQ, NP, X, 1040, tl);
                __syncthreads();
                unsigned raw[64];
#pragma unroll
                for (int t = 0; t < 64; ++t) raw[t] = *(const LAS bf16*)(X + t * 1040 + (role * 256 + dkt) * 2);
                __syncthreads();
                { const int wv = __builtin_amdgcn_readfirstlane(tl >> 6);
#pragma unroll
                  for (int j = 0; j < 2; ++j) { const int c = (wv * 2 + j) * 16; gate_tile(LR + row0 * 32, p.gw2, p.gb, dir, c, c, qd, fr, fq); } }
                __syncthreads();
                v4u lap[8];
#pragma unroll
                for (int j = 0; j < 8; ++j) lap[j] = *(const LAS v4u*)(qd + dkt * TP + 8 * j);
                __syncthreads();
                float run = 0.f;
#pragma unroll
                for (int t = 0; t < 64; ++t) {
                    const unsigned pr = lap[t >> 3][(t >> 1) & 3];
                    const float l = (t & 1) ? bfhi(pr) : bflo(pr);
                    const float cq = dir ? (total - run) : (run + l);
                    run += l;
                    const float v = __builtin_bit_cast(float, raw[t] << 16) * mul * __expf(sgn * cq);
                    dst[t * QP] = (bf16)(pk2(v, 0.f) & 0xffffu); }
            }
            __syncthreads();
            if (MODE != 3) {
                bf16x8 As[8][2];
                { const bf16* sbq = SB + ((size_t)(((dir * 2 + b) * 128 + n) * 4) + h) * 8192 + (size_t)fr * 64 + fq * 8;
#pragma unroll
                  for (int dvt = 0; dvt < 8; ++dvt)
#pragma unroll
                      for (int kk = 0; kk < 2; ++kk) As[dvt][kk] = *(const bf16x8*)(sbq + (size_t)dvt * 1024 + kk * 32); }
                bf16x8 Bq[2][2];
#pragma unroll
                for (int tt = 0; tt < 2; ++tt)
#pragma unroll
                    for (int kk = 0; kk < 2; ++kk) Bq[tt][kk] = *(const LAS bf16x8*)(qd + (th * 32 + tt * 16 + fr) * QP + h * 64 + kk * 32 + fq * 8);
                unsigned pj[4][2][2];
#pragma unroll
                for (int jj = 0; jj < 4; ++jj) {
                    bf16x8 Ak[2];
#pragma unroll
                    for (int kk = 0; kk < 2; ++kk) Ak[kk] = *(const LAS bf16x8*)(kd + (jj * 16 + fr) * QP + h * 64 + kk * 32 + fq * 8);
#pragma unroll
                    for (int tt = 0; tt < 2; ++tt) { f32x4 st = {0.f, 0.f, 0.f, 0.f}; st = MFMA16(Ak[0], Bq[tt][0], st); st = MFMA16(Ak[1], Bq[tt][1], st);
                        const int t = th * 32 + tt * 16 + fr, j0 = jj * 16 + fq * 4;
#pragma unroll
                        for (int i = 0; i < 4; ++i) { const bool keep = dir ? (j0 + i >= t) : (j0 + i <= t); st[i] = keep ? st[i] : 0.f; }
                        pj[jj][tt][0] = pk2(st[0], st[1]); pj[jj][tt][1] = pk2(st[2], st[3]); }
                }
#pragma unroll
                for (int dvt = 0; dvt < 8; ++dvt) {
                    const LAS bf16* vrow = vT + (h * 128 + dvt * 16 + fr) * TP + fq * 4;
#pragma unroll
                    for (int ks = 0; ks < 2; ++ks) {
                        const v2u a0 = *(const LAS v2u*)(vrow + (2 * ks) * 16), a1 = *(const LAS v2u*)(vrow + (2 * ks + 1) * 16);
                        v4u av; av.x = a0.x; av.y = a0.y; av.z = a1.x; av.w = a1.y;
                        const bf16x8 Av = __builtin_bit_cast(bf16x8, av);
#pragma unroll
                        for (int tt = 0; tt < 2; ++tt) { v4u bv; bv.x = pj[2 * ks][tt][0]; bv.y = pj[2 * ks][tt][1]; bv.z = pj[2 * ks + 1][tt][0]; bv.w = pj[2 * ks + 1][tt][1];
                            oacc[dvt][tt] = MFMA16(Av, __builtin_bit_cast(bf16x8, bv), oacc[dvt][tt]); }
                    }
#pragma unroll
                    for (int kk = 0; kk < 2; ++kk) {
#pragma unroll
                        for (int tt = 0; tt < 2; ++tt) oacc[dvt][tt] = MFMA16(As[dvt][kk], Bq[tt][kk], oacc[dvt][tt]); }
                }
            }
        }
        if (MODE != 4) {
            int te = tid; asm volatile("" : "+v"(te)); const int fr = te & 15, fq = (te >> 4) & 3;
            v2u zz[2][8]; f32x4 gg[8];
#pragma unroll
            for (int dvt = 0; dvt < 8; ++dvt) { gg[dvt] = *(const f32x4*)(p.bng + h * 128 + dvt * 16 + fq * 4);
#pragma unroll
                for (int tt = 0; tt < 2; ++tt) zz[tt][dvt] = *(const v2u*)(P + (row0 + th * 32 + tt * 16 + fr) * NP + CZB + h * 128 + dvt * 16 + fq * 4); }
#pragma unroll
            for (int tt = 0; tt < 2; ++tt) {
                float ss = 0.f;
#pragma unroll
                for (int dvt = 0; dvt < 8; ++dvt) { const f32x4 o = oacc[dvt][tt]; ss += (o[0] * o[0] + o[1] * o[1]) + (o[2] * o[2] + o[3] * o[3]); }
                ss += __shfl_xor(ss, 16); ss += __shfl_xor(ss, 32);
                const float rstd = rsqrtf(ss * (1.0f / 128.0f) + EPS);
                const size_t row = row0 + th * 32 + tt * 16 + fr;
#pragma unroll
                for (int dvt = 0; dvt < 8; ++dvt) { const int cc = h * 128 + dvt * 16 + fq * 4;
                    const v2u z = zz[tt][dvt]; const f32x4 g = gg[dvt]; const f32x4 o = oacc[dvt][tt];
                    v2u w; w.x = pk2(o[0] * rstd * g.x * siluf_(bflo(z.x)), o[1] * rstd * g.y * siluf_(bfhi(z.x)));
                    w.y = pk2(o[2] * rstd * g.z * siluf_(bflo(z.y)), o[3] * rstd * g.w * siluf_(bfhi(z.y)));
                    *(v2u*)(A2 + row * 1024 + 512 + cc) = w; }
            }
        }
        __syncthreads();
    }
    constexpr int VP = 136;
    LAS bf16* vnT = (LAS bf16*)lds;
    if (MODE == 0) for (int item = blockIdx.x; item < 512; item += gridDim.x) {
        const int b = item >> 8, g = (item >> 6) & 3, ci = item & 63;
        const size_t base = (size_t)b * SEQ + (g < 2 ? ci * 128 : ci); const int stride = g < 2 ? 1 : 64;
        {
            const int c = tid & 127, jq = tid >> 7;
            const bf16* src = P + (base + (size_t)(jq * 32) * stride) * NP + CVA + g * 128 + c;
            unsigned w[16];
#pragma unroll
            for (int j = 0; j < 16; ++j) { const unsigned a = src[(size_t)(2 * j) * stride * NP], bq = src[(size_t)(2 * j + 1) * stride * NP]; w[j] = a | (bq << 16); }
#pragma unroll
            for (int j = 0; j < 4; ++j) { v4u o; o.x = w[4 * j]; o.y = w[4 * j + 1]; o.z = w[4 * j + 2]; o.w = w[4 * j + 3]; *(LAS v4u*)(vnT + c * VP + jq * 32 + 8 * j) = o; }
        }
        __syncthreads();
        {
            bf16x8 Bw[4];
#pragma unroll
            for (int kk = 0; kk < 4; ++kk) Bw[kk] = *(const bf16x8*)(WSB + (size_t)(g * 128 + wave * 16 + fr) * 128 + kk * 32 + fq * 8);
            const size_t tok = base + (size_t)(wave * 16 + fr) * stride;
            const float bsv = p.a_bs[g * 128 + wave * 16 + fr];
#pragma unroll
            for (int ct = 0; ct < 8; ++ct) {
                f32x4 acc = {0.f, 0.f, 0.f, 0.f};
#pragma unroll
                for (int kk = 0; kk < 4; ++kk) { const bf16x8 Av = *(const LAS bf16x8*)(vnT + (ct * 16 + fr) * VP + kk * 32 + fq * 8); acc = MFMA16(Av, Bw[kk], acc); }
                const int cc = g * 128 + ct * 16 + fq * 4;
                const v2u u = *(const v2u*)(P + tok * NP + (g < 2 ? CUA + g * 256 : CZA + (g - 2) * 256) + ct * 16 + fq * 4);
                v2u w; w.x = pk2(bflo(u.x) * (acc[0] + bsv), bfhi(u.x) * (acc[1] + bsv));
                w.y = pk2(bflo(u.y) * (acc[2] + bsv), bfhi(u.y) * (acc[3] + bsv));
                *(v2u*)(A2 + tok * 1024 + cc) = w;
            }
        }
        __syncthreads();
    }
}

struct EpiP {
    static constexpr bool PERM = true, AFTER_DRAIN = false, MID = false;
    bf16* O;
    __device__ __forceinline__ void mid(pg8::f32x4 (&)[2][2][4][2], const pg8::Unit&, int, int, int, int) const {}
    __device__ __forceinline__ void operator()(pg8::f32x4 (&acc)[2][2][4][2], const pg8::Unit& u, int wr, int wc, int fr, int fq) const {
        const int row0 = u.pm * 256 + wr * 64 + fr, col0 = u.pn * 256 + wc * 32 + 8 * fq;
#pragma unroll
        for (int ai = 0; ai < 2; ++ai)
#pragma unroll
            for (int m = 0; m < 4; ++m) { bf16* rowp = O + (size_t)(row0 + ai * 128 + m * 16) * NP + col0;
                pg8::f32x4 g00 = acc[ai][0][m][0], g01 = acc[ai][0][m][1], g10 = acc[ai][1][m][0], g11 = acc[ai][1][m][1];
                if (u.pn >= CG / 256) {
#pragma unroll
                    for (int k = 0; k < 4; ++k) {
                        const float ea = __expf(-g10[k]), sa = __builtin_amdgcn_rcpf(1.0f + __expf(-g00[k])); g00[k] = sa * (1.0f + ea); g10[k] = __builtin_amdgcn_rcpf(1.0f + ea);
                        const float eb = __expf(-g11[k]), sb = __builtin_amdgcn_rcpf(1.0f + __expf(-g01[k])); g01[k] = sb * (1.0f + eb); g11[k] = __builtin_amdgcn_rcpf(1.0f + eb); } }
                const bool uz = (u.pn == CUA / 256) | (u.pn == CUA / 256 + 1) | (u.pn == CZA / 256) | (u.pn == CZA / 256 + 1);
                if (uz) {
#pragma unroll
                    for (int k = 0; k < 4; ++k) { g00[k] = g00[k] * g10[k] * __builtin_amdgcn_rcpf(1.0f + __expf(-g10[k])); g01[k] = g01[k] * g11[k] * __builtin_amdgcn_rcpf(1.0f + __expf(-g11[k])); } }
                { v4u w; w.x = pk2(g00[0], g00[1]); w.y = pk2(g00[2], g00[3]); w.z = pk2(g01[0], g01[1]); w.w = pk2(g01[2], g01[3]); *(v4u*)(rowp) = w; }
                if (!uz) { v4u w; w.x = pk2(g10[0], g10[1]); w.y = pk2(g10[2], g10[3]); w.z = pk2(g11[0], g11[1]); w.w = pk2(g11[2], g11[3]); *(v4u*)(rowp + 128) = w; } }
    }
};
struct EpiMerge {
    static constexpr bool PERM = true, AFTER_DRAIN = false, MID = true;
    const bf16* P; bf16* O;
    __device__ __forceinline__ void mid(pg8::f32x4 (&acc)[2][2][4][2], const pg8::Unit& u, int wr, int wc, int fr, int fq) const {
        asm volatile("" : "+v"(fr), "+v"(fq));
        const int row0 = u.pm * 256 + wr * 64 + fr, gc0 = CG + u.pn * 512 + wc * 32 + 8 * fq;
#pragma unroll
        for (int ai = 0; ai < 2; ++ai)
#pragma unroll
            for (int m = 0; m < 4; ++m) { const bf16* gp = P + (size_t)(row0 + ai * 128 + m * 16) * NP + gc0;
#pragma unroll
                for (int bj = 0; bj < 2; ++bj) { const v4u a1 = *(const v4u*)(gp + bj * 256);
                    const float r[8] = {bflo(a1.x), bfhi(a1.x), bflo(a1.y), bfhi(a1.y), bflo(a1.z), bfhi(a1.z), bflo(a1.w), bfhi(a1.w)};
#pragma unroll
                    for (int e = 0; e < 8; ++e) acc[ai][bj][m][e >> 2][e & 3] *= r[e]; } }
    }
    __device__ __forceinline__ void operator()(pg8::f32x4 (&acc)[2][2][4][2], const pg8::Unit& u, int wr, int wc, int fr, int fq) const {
        const int row0 = u.pm * 256 + wr * 64 + fr, col0 = u.pn * 256 + wc * 32 + 8 * fq, gc0 = CG + u.pn * 512 + 128 + wc * 32 + 8 * fq;
#pragma unroll
        for (int ai = 0; ai < 2; ++ai)
#pragma unroll
            for (int m = 0; m < 4; ++m) { const size_t row = (size_t)(row0 + ai * 128 + m * 16); const bf16* gp = P + row * NP + gc0;
#pragma unroll
                for (int bj = 0; bj < 2; ++bj) { const v4u a2 = *(const v4u*)(gp + bj * 256);
                    const float s2[8] = {bflo(a2.x), bfhi(a2.x), bflo(a2.y), bfhi(a2.y), bflo(a2.z), bfhi(a2.z), bflo(a2.w), bfhi(a2.w)};
                    float o[8];
#pragma unroll
                    for (int e = 0; e < 8; ++e) o[e] = acc[ai][bj][m][e >> 2][e & 3] * s2[e];
                    v4u w; w.x = pk2(o[0], o[1]); w.y = pk2(o[2], o[3]); w.z = pk2(o[4], o[5]); w.w = pk2(o[6], o[7]);
                    *(v4u*)(O + row * 1024 + col0 + bj * 128) = w; } }
    }
};
struct EpiFinal {
    static constexpr bool PERM = false, AFTER_DRAIN = true, MID = false;
    const float *x, *MOD, *fng; float *PART, *out; int split; const XcdBarrier* bar;
    __device__ __forceinline__ void mid(pg8::f32x4 (&)[2][2][4][2], const pg8::Unit&, int, int, int, int) const {}
    __device__ __forceinline__ void operator()(pg8::f32x4 (&)[2][2][4][2], const pg8::Unit&, int, int, int, int) const {}
    __device__ __forceinline__ void fused(pg8::f32x4 (&acc)[2][2][4][2], const pg8::Unit& u, int wr, int wc, int fr, int fq, PG8_LAS unsigned char*, int, int) const {
        const int row0 = u.pm * 256 + wr * 64 + fr, col0 = u.pn * 256 + wc * 32 + 4 * fq;
        const float* gate = MOD + (u.pm >> 5) * 3072 + 2048 + col0;
        {
            f32x4 gt[2][2];
#pragma unroll
            for (int bj = 0; bj < 2; ++bj)
#pragma unroll
                for (int n = 0; n < 2; ++n) gt[bj][n] = *(const f32x4*)(gate + bj * 128 + n * 16) + *(const f32x4*)(gate + 9216 + bj * 128 + n * 16);
#pragma unroll
            for (int ai = 0; ai < 2; ++ai)
#pragma unroll
                for (int m = 0; m < 4; ++m) { const size_t row = (size_t)(row0 + ai * 128 + m * 16); const float* xr = x + row * 1024 + col0; float ss = 0.f;
#pragma unroll
                    for (int bj = 0; bj < 2; ++bj)
#pragma unroll
                        for (int n = 0; n < 2; ++n) { const f32x4 xv = *(const f32x4*)(xr + bj * 128 + n * 16); const f32x4 v = xv + gt[bj][n] * acc[ai][bj][m][n]; acc[ai][bj][m][n] = v;
                            ss += (v[0] * v[0] + v[1] * v[1]) + (v[2] * v[2] + v[3] * v[3]); }
                    ss += __shfl_xor(ss, 16); ss += __shfl_xor(ss, 32);
                    if (fq == 0) PART[((size_t)u.pn * M + row) * 4 + wc] = ss; }
        }
        if (split) {
#pragma unroll
            for (int ai = 0; ai < 2; ++ai)
#pragma unroll
                for (int m = 0; m < 4; ++m) { float* orow = out + (size_t)(row0 + ai * 128 + m * 16) * 1024 + col0;
#pragma unroll
                    for (int bj = 0; bj < 2; ++bj)
#pragma unroll
                        for (int n = 0; n < 2; ++n) *(f32x4*)(orow + bj * 128 + n * 16) = acc[ai][bj][m][n]; }
            return;
        }
        xcd_barrier(*bar);
        {
            f32x4 fg[2][2];
#pragma unroll
            for (int bj = 0; bj < 2; ++bj)
#pragma unroll
                for (int n = 0; n < 2; ++n) fg[bj][n] = *(const f32x4*)(fng + col0 + bj * 128 + n * 16);
#pragma unroll
            for (int ai = 0; ai < 2; ++ai)
#pragma unroll
                for (int m = 0; m < 4; ++m) { const size_t row = (size_t)(row0 + ai * 128 + m * 16); const f32x4* pp = (const f32x4*)(PART + row * 4);
                    const f32x4 p0 = pp[0], p1 = pp[M], p2 = pp[2 * M], p3 = pp[3 * M];
                    const float tot = ((p0[0] + p0[1]) + (p0[2] + p0[3])) + ((p1[0] + p1[1]) + (p1[2] + p1[3])) + ((p2[0] + p2[1]) + (p2[2] + p2[3])) + ((p3[0] + p3[1]) + (p3[2] + p3[3]));
                    const float rstd = rsqrtf(tot * (1.0f / 1024.0f) + EPS);
                    float* orow = out + row * 1024 + col0;
#pragma unroll
                    for (int bj = 0; bj < 2; ++bj)
#pragma unroll
                        for (int n = 0; n < 2; ++n) *(f32x4*)(orow + bj * 128 + n * 16) = acc[ai][bj][m][n] * rstd * fg[bj][n]; }
        }
    }
};

__global__ void __launch_bounds__(NTHR) fwd_megakernel(Params p) {
    extern __shared__ __attribute__((aligned(16))) unsigned char lds_raw[];
    LAS unsigned char* lds = (LAS unsigned char*)lds_raw;
    cg::grid_group grid = cg::this_grid();
    unsigned char* ws = p.ws;
#define IN(k) (p.ph_lo <= (k) && (k) < p.ph_hi)
#define SEAM(k) do { if (IN(k) && IN((k) + 1)) { xcd_barrier(xbar); } } while (0)
    volatile LAS unsigned* xst = (volatile LAS unsigned*)(lds + LDS_BYTES - 16);
    if (threadIdx.x == 0) { xst[0] = 0u; xst[1] = 0u; }
    __syncthreads();
    const XcdBarrier xbar = xcd_barrier_post((unsigned*)(ws + WS_BAR), xst);
    if (p.ph_lo < 0) grid.sync();
#ifndef PROBE
#define PROBE 0
#endif
    if (PROBE == 1) { for (int i = 0; i < 8; ++i) xcd_barrier(xbar); }
    if (IN(0)) phase0(p, lds);
    SEAM(0);
    if (PROBE == 4) { phase0(p, lds); xcd_barrier(xbar); }
    if (IN(1)) phase1(p, lds);
    SEAM(1);
    if (PROBE == 4) { phase1(p, lds); xcd_barrier(xbar); }
    if (IN(2)) {
        pg8::Gemm g{(const bf16*)((unsigned char*)p.out + OUT_H), (const bf16*)(ws + WS_WIT), M, NP, D}; pg8::StaticOrder S; S.init(M, NP, (int)gridDim.x, (int)blockIdx.x);
        EpiP E{(bf16*)(ws + WS_P)};
        pg8::gemm_phase<EpiP, pg8::StaticOrder, true, true>(lds, g, S, E);
    }
    SEAM(2);
    if (PROBE == 5) {
        pg8::Gemm g{(const bf16*)((unsigned char*)p.out + OUT_H), (const bf16*)(ws + WS_WIT), M, NP, D}; pg8::StaticOrder S; S.init(M, NP, (int)gridDim.x, (int)blockIdx.x);
        EpiP E{(bf16*)(ws + WS_P)};
        pg8::gemm_phase<EpiP, pg8::StaticOrder, true, true>(lds, g, S, E);
        xcd_barrier(xbar);
    }
    if (IN(3)) phase3a<0>(p, lds, true);
    SEAM(3);
    if (PROBE == 3) { phase3a<0>(p, lds, false); xcd_barrier(xbar); }
    if (PROBE == 11) { phase3a<1>(p, lds, false); xcd_barrier(xbar); }
    if (PROBE == 12) { phase3a<2>(p, lds, false); xcd_barrier(xbar); }
    if (PROBE == 13) { phase3a<3>(p, lds, false); xcd_barrier(xbar); }
    if (PROBE == 14) { phase3a<4>(p, lds, false); xcd_barrier(xbar); }
    if (IN(4)) phase3b(p);
    SEAM(4);
    if (PROBE == 3) { phase3b(p); xcd_barrier(xbar); }
    if (IN(5)) phase3c<0>(p, lds);
    SEAM(5);
    if (PROBE == 2) { phase3c<0>(p, lds); xcd_barrier(xbar); }
    if (PROBE == 21) { phase3c<1>(p, lds); xcd_barrier(xbar); }
    if (PROBE == 22) { phase3c<2>(p, lds); xcd_barrier(xbar); }
    if (PROBE == 23) { phase3c<3>(p, lds); xcd_barrier(xbar); }
    if (PROBE == 24) { phase3c<4>(p, lds); xcd_barrier(xbar); }
    if (PROBE == 25) { phase3c<5>(p, lds); xcd_barrier(xbar); }
    if (IN(6)) {
        pg8::Gemm g{(const bf16*)((unsigned char*)p.out + OUT_H), (const bf16*)(ws + WS_W2T), M, D, D}; pg8::StaticOrder S; S.init(M, D, (int)gridDim.x, (int)blockIdx.x);
        EpiMerge E{(const bf16*)(ws + WS_P), (bf16*)(ws + WS_MBUF)};
        pg8::gemm_phase<EpiMerge, pg8::StaticOrder, true, true>(lds, g, S, E);
    }
    SEAM(6);
    if (PROBE == 6) {
        pg8::Gemm g{(const bf16*)((unsigned char*)p.out + OUT_H), (const bf16*)(ws + WS_W2T), M, D, D}; pg8::StaticOrder S; S.init(M, D, (int)gridDim.x, (int)blockIdx.x);
        EpiMerge E{(const bf16*)(ws + WS_P), (bf16*)(ws + WS_MBUF)};
        pg8::gemm_phase<EpiMerge, pg8::StaticOrder, true, true>(lds, g, S, E);
        xcd_barrier(xbar);
    }
    if (IN(7)) {
        pg8::Gemm g{(const bf16*)(ws + WS_MBUF), (const bf16*)(ws + WS_WOT), M, D, D}; pg8::StaticOrder S; S.init(M, D, (int)gridDim.x, (int)blockIdx.x);
        EpiFinal E{p.x, (const float*)(ws + WS_MODP), p.fng, (float*)(ws + WS_PART), p.out, p.ph_hi - p.ph_lo < 9 ? 1 : 0, &xbar};
        pg8::gemm_phase<EpiFinal, pg8::StaticOrder, false, true>(lds, g, S, E);
    }
    SEAM(7);
    if (IN(8) && (p.ph_hi - p.ph_lo < 9)) {
        const int lane = threadIdx.x & 63, wave = threadIdx.x >> 6; const float* PART = (const float*)(ws + WS_PART);
        for (int row = blockIdx.x * 8 + wave; row < M; row += gridDim.x * 8) {
            const f32x4* pp = (const f32x4*)(PART + (size_t)row * 4); const f32x4 p0 = pp[0], p1 = pp[M], p2 = pp[2 * M], p3 = pp[3 * M];
            const float tot = ((p0[0] + p0[1]) + (p0[2] + p0[3])) + ((p1[0] + p1[1]) + (p1[2] + p1[3])) + ((p2[0] + p2[1]) + (p2[2] + p2[3])) + ((p3[0] + p3[1]) + (p3[2] + p3[3]));
            const float rstd = rsqrtf(tot * (1.0f / 1024.0f) + EPS);
            f32x4* orow = (f32x4*)(p.out + (size_t)row * 1024);
#pragma unroll
            for (int j = 0; j < 4; ++j) orow[lane + 64 * j] = orow[lane + 64 * j] * rstd * ((const f32x4*)p.fng)[lane + 64 * j];
        }
    }
    if (IN(9)) {
        float* o = (float*)((unsigned char*)p.out + OUT_SB); const bf16* P = (const bf16*)(ws + WS_P);
        for (size_t i = (size_t)blockIdx.x * NTHR + threadIdx.x; i < 8388608; i += (size_t)gridDim.x * NTHR) { float a = 0.f; for (int j = 0; j < 10; ++j) a += bf1(P[i * 10 + j]); o[i] = a; }
    }
    if (IN(10)) {
        float* o = (float*)((unsigned char*)p.out + OUT_SB);
        const float* LR = (const float*)(ws + WS_LR); const float* LRC = (const float*)(ws + WS_LRC); const bf16* PCKV = (const bf16*)(ws + WS_PCKV);
        const float* DEC = (const float*)(ws + WS_DEC); const float* TOT = (const float*)(ws + WS_TOT); const float* MOD = (const float*)(ws + WS_MOD); const bf16* KV = (const bf16*)(ws + WS_KV);
        const size_t g0 = (size_t)blockIdx.x * NTHR + threadIdx.x, gs = (size_t)gridDim.x * NTHR;
#ifndef DUMP_SEL
#define DUMP_SEL 63
#endif
        if (DUMP_SEL & 1) for (size_t i = g0; i < 524288; i += gs) o[i] = LR[i];
        if (DUMP_SEL & 2) for (size_t i = g0; i < 16384; i += gs) o[600000 + i] = LRC[i];
        if (DUMP_SEL & 4) for (size_t i = g0; i < 393216; i += gs) o[700000 + i] = bf1(PCKV[i]);
        if (DUMP_SEL & 8) for (size_t i = g0; i < 135168; i += gs) o[1200000 + i] = DEC[i];
        if (DUMP_SEL & 16) for (size_t i = g0; i < 65536; i += gs) o[1400000 + i] = TOT[i];
        if (DUMP_SEL & 32) for (size_t i = g0; i < 8192; i += gs) o[1500000 + i] = MOD[i < 6144 ? i : 8192 + (i - 6144)];
        if (DUMP_SEL & 128) for (size_t i = g0; i < 4325376; i += gs) { float a = 0.f; for (int j = 0; j < 4; ++j) a += bf1(KV[i * 4 + j]); if ((((i * 4) >> 13) & 3) < 2) o[2000000 + i] = a; }
        if (DUMP_SEL & 256) for (size_t i = g0; i < 4325376; i += gs) { float a = 0.f; for (int j = 0; j < 4; ++j) a += bf1(KV[i * 4 + j]); if ((((i * 4) >> 13) & 3) >= 2) o[2000000 + i] = a; }
        if (DUMP_SEL & 64) for (size_t i = g0; i < 4325376; i += gs) { float a = 0.f; for (int j = 0; j < 4; ++j) a += bf1(KV[i * 4 + j]); o[2000000 + i] = a; }
    }
#undef IN
#undef SEAM
}

extern "C" void kernel_launch(void* const* d_in, const int* in_sizes, int n_in, void* d_out, int out_size, void* d_ws, size_t ws_size, hipStream_t stream) {
    static int grid = 0;
    if (grid == 0) {
        if (n_in != 19 || out_size != M * D || ws_size < WS_END) { fprintf(stderr, "kernel_launch: unexpected shapes (n_in %d out %d ws %zu)\n", n_in, out_size, ws_size); grid = -1; return; }
        int dev = 0, cus = 0, per_cu = 0;
        hipGetDevice(&dev); hipDeviceGetAttribute(&cus, hipDeviceAttributeMultiprocessorCount, dev);
        if (hipFuncSetAttribute((const void*)fwd_megakernel, hipFuncAttributeMaxDynamicSharedMemorySize, LDS_BYTES) != hipSuccess) { fprintf(stderr, "kernel_launch: hipFuncSetAttribute failed\n"); grid = -1; return; }
        hipOccupancyMaxActiveBlocksPerMultiprocessor(&per_cu, (const void*)fwd_megakernel, NTHR, LDS_BYTES);
        if (cus * per_cu < 256) { fprintf(stderr, "kernel_launch: need 256 co-resident workgroups, have %d x %d\n", cus, per_cu); grid = -1; return; }
        grid = 256;
    }
    if (grid < 0) return;
    Params p{};
    p.x = (const float*)d_in[0]; p.c = (const float*)d_in[1]; p.ctx = (const float*)d_in[2]; p.c_ctx = (const float*)d_in[3]; p.w_mod = (const float*)d_in[4]; p.b_mod = (const float*)d_in[5];
    p.norm_g = (const float*)d_in[6]; p.w_in = (const float*)d_in[7]; p.a_ln_g = (const float*)d_in[8]; p.a_ln_b = (const float*)d_in[9]; p.a_ws = (const float*)d_in[10]; p.a_bs = (const float*)d_in[11];
    p.gw2 = (const float*)d_in[12]; p.gb = (const float*)d_in[13]; p.bng = (const float*)d_in[14]; p.wpa = (const float*)d_in[15]; p.wpb = (const float*)d_in[16]; p.w_out = (const float*)d_in[17]; p.fng = (const float*)d_in[18];
    p.out = (float*)d_out; p.ws = (unsigned char*)d_ws;
#ifndef MK_CUTS
#define MK_CUTS 1
#endif
#ifndef MK_DBG
#define MK_DBG 0
#endif
#ifndef MK_SEQ
#define MK_SEQ 0, 1, 10
#endif
    const int seq_dbg[] = {MK_SEQ}; const int nseq = (int)(sizeof(seq_dbg) / sizeof(int));
    if (hipMemsetAsync((unsigned char*)d_ws + WS_BAR, 0, XCD_BAR_WORDS * 4, stream) != hipSuccess) { fprintf(stderr, "kernel_launch: memset failed\n"); return; }
    for (int li = 0; li < (MK_DBG ? nseq : MK_CUTS); ++li) {
        p.ph_lo = (MK_CUTS == 1) ? 0 : li; p.ph_hi = (MK_CUTS == 1) ? 9 : li + 1;
        if (MK_DBG) { p.ph_lo = seq_dbg[li]; p.ph_hi = seq_dbg[li] + 1; }
        void* args[] = {&p};
        hipError_t e = hipLaunchCooperativeKernel((const void*)fwd_megakernel, dim3(grid), dim3(NTHR), args, LDS_BYTES, stream);
        if (e != hipSuccess) fprintf(stderr, "cooperative launch failed: %s\n", hipGetErrorString(e));
    }
}
```

```cpp
#include <hip/hip_runtime.h>
#include <hip/hip_cooperative_groups.h>
#include <cstdio>
#include <cstdint>
namespace cg = cooperative_groups;

namespace pg8 {
#define PG8_LAS __attribute__((address_space(3)))
typedef unsigned short bf16_t;
typedef short bf16x8 __attribute__((ext_vector_type(8)));
typedef float f32x4 __attribute__((ext_vector_type(4)));
typedef unsigned u32x4 __attribute__((ext_vector_type(4)));
constexpr int BM = 256, BK = 64, HALF = 128, HTB = HALF * BK * 2, STAGE_BYTES = 8 * HTB, NXCD = 8, WGM = 8;

__host__ __device__ __forceinline__ int lds_byte(int r, int c) { const int st = (r >> 4) * 2 + (c >> 5), rr = r & 15, cc = c & 31, ob = rr * 64 + cc * 2; return st * 1024 + (ob ^ (((ob >> 9) & 1) << 5)); }
__host__ __device__ __forceinline__ void stage_rc(int b, int& R, int& C) { const int st = b / 1024, sb = b % 1024, swz = sb ^ (((sb >> 9) & 1) << 5); R = (st >> 1) * 16 + swz / 64; C = (st & 1) * 32 + (swz % 64) / 2; }
__host__ __device__ __forceinline__ int perm32(int rho) { const int n = rho >> 4, i = rho & 15; return 8 * (i >> 2) + 4 * n + (i & 3); }

struct Unit { int pm, pn; };
struct Gemm { const bf16_t* A; const bf16_t* Bt; int M, N, K; };

struct StaticOrder {
    int nM, nN, nwg, G, c;
    __host__ __device__ void init(int M, int N, int G_, int c_) { nM = M / BM; nN = N / BM; nwg = nM * nN; G = G_; c = c_; }
    __host__ __device__ bool next(int i, Unit& u) const {
        const long L = (long)i * G + c; if (L >= nwg) return false;
        int wgid = (int)L; { const int q = nwg / NXCD, r = nwg % NXCD, xcd = wgid % NXCD, off = wgid / NXCD; wgid = (xcd < r ? xcd * (q + 1) : r * (q + 1) + (xcd - r) * q) + off; }
        const int nig = WGM * nN, gid = wgid / nig, fm = gid * WGM, gsz = (nM - fm) < WGM ? (nM - fm) : WGM;
        u.pm = fm + ((wgid % nig) % gsz); u.pn = (wgid % nig) / gsz; return true;
    }
    __device__ __forceinline__ void a_ready(const Unit&) const {}
    __device__ __forceinline__ void done(const Unit&) const {}
};
typedef __bf16 bf16v2_t __attribute__((ext_vector_type(2)));
typedef float f32v2_t __attribute__((ext_vector_type(2)));
__device__ __forceinline__ unsigned cvt_pk_bf16(float lo, float hi) { const f32v2_t v = {lo, hi}; return __builtin_bit_cast(unsigned, __builtin_convertvector(v, bf16v2_t)); }

template <class Epi, class Sched, bool ALIGN_EPI = false, bool SP2 = false>
__device__ __forceinline__ void gemm_phase(PG8_LAS unsigned char* lds, const Gemm g, const Sched& S, const Epi& E) {
    const int tid = threadIdx.x, wid = __builtin_amdgcn_readfirstlane(tid >> 6), lane = tid & 63, wr = wid >> 2, wc = wid & 3, fr = lane & 15, fq = lane >> 4;
    const int K = g.K, nt = K / BK;
    unsigned voffA[2], voffB[2];
#pragma unroll
    for (int i = 0; i < 2; ++i) { int R, C; stage_rc(tid * 16 + i * 8192, R, C); const int Rb = Epi::PERM ? ((R & ~31) + perm32(R & 31)) : R;
        voffA[i] = (unsigned)(R * K + C) * 2u; voffB[i] = (unsigned)(Rb * K + C) * 2u; }
    const size_t kstep = (size_t)(BK * 2);
    const size_t hstep = (size_t)HALF * K * 2;
    const size_t tstep = 2 * hstep;
    const unsigned ldsw = (unsigned)wid * 1024u;
    const int aoff = lds_byte(wr * 64 + fr, fq * 8), boff = lds_byte(wc * 32 + fr, fq * 8);
#define PG8_SA(b, h) (((b) * 2 + (h)) * HTB)
#define PG8_SB(b, h) ((4 + (b) * 2 + (h)) * HTB)
#define PG8_STAGE(bufoff, gbase, voff) do { _Pragma("unroll") for (int _i = 0; _i < 2; ++_i) \
        __builtin_amdgcn_global_load_lds((const unsigned*)((const char*)(gbase) + (voff)[_i]), (PG8_LAS unsigned*)(lds + (bufoff) + ldsw + _i * 8192), 16, 0, 0); } while (0)
#define PG8_LDA(dst, b, h) do { _Pragma("unroll") for (int m = 0; m < 4; ++m) _Pragma("unroll") for (int k = 0; k < 2; ++k) dst[m][k] = *(const PG8_LAS bf16x8*)(lds + PG8_SA(b, h) + aoff + m * 2048 + k * 1024); } while (0)
#define PG8_LDB(dst, b, h) do { _Pragma("unroll") for (int n = 0; n < 2; ++n) _Pragma("unroll") for (int k = 0; k < 2; ++k) dst[n][k] = *(const PG8_LAS bf16x8*)(lds + PG8_SB(b, h) + boff + n * 2048 + k * 1024); } while (0)
#define PG8_MMA(ai, bj, At, Bt) do { __builtin_amdgcn_s_setprio(1); _Pragma("unroll") for (int m = 0; m < 4; ++m) _Pragma("unroll") for (int n = 0; n < 2; ++n) _Pragma("unroll") for (int k = 0; k < 2; ++k) \
        acc[ai][bj][m][n] = __builtin_amdgcn_mfma_f32_16x16x32_bf16(Bt[n][k], At[m][k], acc[ai][bj][m][n], 0, 0, 0); __builtin_amdgcn_s_setprio(0); } while (0)
#define PG8_WAIT_V(n) asm volatile("s_waitcnt vmcnt(" #n ")" ::: "memory")
#define PG8_WAIT_L(n) asm volatile("s_waitcnt lgkmcnt(" #n ")" ::: "memory")
#define PG8_BAR __builtin_amdgcn_s_barrier()
#define PG8_SCHED __builtin_amdgcn_sched_barrier(0)
    Unit cur, nxt; int ui = 0;
    if (!S.next(0, cur)) return;
    f32x4 acc[2][2][4][2];
#pragma unroll
    for (int a = 0; a < 2; ++a)
#pragma unroll
        for (int b = 0; b < 2; ++b)
#pragma unroll
            for (int m = 0; m < 4; ++m)
#pragma unroll
                for (int n = 0; n < 2; ++n) acc[a][b][m][n] = (f32x4){0.f, 0.f, 0.f, 0.f};
    bf16x8 At[4][2], B0[2][2], B1[2][2];
    const char* cA = (const char*)g.A + (size_t)cur.pm * tstep; const char* cB = (const char*)g.Bt + (size_t)cur.pn * tstep;
    S.a_ready(cur);
    if constexpr (SP2) {
        PG8_STAGE(PG8_SB(0, 0), cB, voffB); PG8_STAGE(PG8_SB(0, 1), cB + hstep, voffB); PG8_STAGE(PG8_SA(0, 0), cA, voffA); PG8_STAGE(PG8_SA(0, 1), cA + hstep, voffA);
        if (wr == 1) PG8_BAR;
        PG8_WAIT_V(2); PG8_BAR;
        PG8_STAGE(PG8_SB(1, 0), cB + kstep, voffB); PG8_STAGE(PG8_SA(1, 0), cA + kstep, voffA); PG8_STAGE(PG8_SB(1, 1), cB + hstep + kstep, voffB);
        PG8_WAIT_V(6); PG8_BAR;
    } else {
        PG8_STAGE(PG8_SB(0, 0), cB, voffB); PG8_STAGE(PG8_SA(0, 0), cA, voffA); PG8_STAGE(PG8_SB(0, 1), cB + hstep, voffB); PG8_STAGE(PG8_SA(0, 1), cA + hstep, voffA);
        if (wr == 1) PG8_BAR;
        PG8_WAIT_V(4); PG8_BAR;
        PG8_STAGE(PG8_SB(1, 0), cB + kstep, voffB); PG8_STAGE(PG8_SA(1, 0), cA + kstep, voffA); PG8_STAGE(PG8_SB(1, 1), cB + hstep + kstep, voffB);
        PG8_WAIT_V(6); PG8_BAR;
    }
    for (;;) {
        const bool has_next = S.next(ui + 1, nxt);
        const char* nA = has_next ? (const char*)g.A + (size_t)nxt.pm * tstep : cA; const char* nB = has_next ? (const char*)g.Bt + (size_t)nxt.pn * tstep : cB;
        for (int t = 0; t < nt; t += 2) {
            const bool last = (t == nt - 2);
            const char* a1 = cA + (size_t)(t + 1) * kstep;
            const char* a2 = last ? nA : cA + (size_t)(t + 2) * kstep; const char* b2 = last ? nB : cB + (size_t)(t + 2) * kstep;
            const char* a3 = a2 + kstep; const char* b3 = b2 + kstep;
            if (last && has_next) S.a_ready(nxt);
            if constexpr (Epi::MID) { if (t == (nt >> 1)) E.mid(acc, cur, wr, wc, fr, fq); }
            if constexpr (SP2) {
            PG8_LDB(B0, 0, 0); PG8_LDB(B1, 0, 1); PG8_SCHED; PG8_LDA(At, 0, 0); PG8_STAGE(PG8_SA(1, 1), a1 + hstep, voffA);
            PG8_WAIT_V(8); PG8_WAIT_L(0); PG8_BAR; PG8_MMA(0, 0, At, B0); PG8_MMA(0, 1, At, B1); PG8_BAR; PG8_SCHED;
            PG8_LDA(At, 0, 1); PG8_STAGE(PG8_SB(0, 0), b2, voffB); PG8_STAGE(PG8_SB(0, 1), b2 + hstep, voffB); PG8_STAGE(PG8_SA(0, 0), a2, voffA);
            PG8_WAIT_V(8); PG8_WAIT_L(0); PG8_BAR; PG8_MMA(1, 0, At, B0); PG8_MMA(1, 1, At, B1); PG8_BAR; PG8_SCHED;
            PG8_LDB(B0, 1, 0); PG8_LDB(B1, 1, 1); PG8_SCHED; PG8_LDA(At, 1, 0); PG8_STAGE(PG8_SA(0, 1), a2 + hstep, voffA);
            PG8_WAIT_V(8); PG8_WAIT_L(0); PG8_BAR; PG8_MMA(0, 0, At, B0); PG8_MMA(0, 1, At, B1); PG8_BAR; PG8_SCHED;
            PG8_LDA(At, 1, 1); PG8_STAGE(PG8_SB(1, 0), b3, voffB); PG8_STAGE(PG8_SB(1, 1), b3 + hstep, voffB); PG8_STAGE(PG8_SA(1, 0), a3, voffA);
            PG8_WAIT_V(8); PG8_WAIT_L(0); PG8_BAR; PG8_MMA(1, 0, At, B0); PG8_MMA(1, 1, At, B1); PG8_BAR; PG8_SCHED;
            } else {
            PG8_LDB(B0, 0, 0); PG8_SCHED; PG8_LDA(At, 0, 0); PG8_STAGE(PG8_SA(1, 1), a1 + hstep, voffA);
            PG8_WAIT_L(8); PG8_BAR; PG8_WAIT_L(0); PG8_MMA(0, 0, At, B0); PG8_BAR; PG8_SCHED;
            PG8_LDB(B1, 0, 1); PG8_STAGE(PG8_SB(0, 0), b2, voffB);
            PG8_BAR; PG8_WAIT_L(0); PG8_MMA(0, 1, At, B1); PG8_BAR;
            PG8_LDA(At, 0, 1); PG8_STAGE(PG8_SA(0, 0), a2, voffA);
            PG8_BAR; PG8_WAIT_L(0); PG8_MMA(1, 0, At, B0); PG8_BAR; PG8_SCHED;
            PG8_STAGE(PG8_SB(0, 1), b2 + hstep, voffB);
            PG8_WAIT_V(6); PG8_BAR; PG8_MMA(1, 1, At, B1); PG8_BAR;
            PG8_LDB(B0, 1, 0); PG8_SCHED; PG8_LDA(At, 1, 0); PG8_STAGE(PG8_SA(0, 1), a2 + hstep, voffA);
            PG8_WAIT_L(8); PG8_BAR; PG8_WAIT_L(0); PG8_MMA(0, 0, At, B0); PG8_BAR; PG8_SCHED;
            PG8_LDB(B1, 1, 1); PG8_STAGE(PG8_SB(1, 0), b3, voffB);
            PG8_BAR; PG8_WAIT_L(0); PG8_MMA(0, 1, At, B1); PG8_BAR;
            PG8_LDA(At, 1, 1); PG8_STAGE(PG8_SA(1, 0), a3, voffA);
            PG8_BAR; PG8_WAIT_L(0); PG8_MMA(1, 0, At, B0); PG8_BAR; PG8_SCHED;
            PG8_STAGE(PG8_SB(1, 1), b3 + hstep, voffB);
            PG8_WAIT_V(6); PG8_BAR; PG8_MMA(1, 1, At, B1); PG8_BAR;
            }
        }
        if constexpr (ALIGN_EPI) { if (wr == 0) PG8_BAR; }
        if constexpr (!Epi::AFTER_DRAIN) { E(acc, cur, wr, wc, fr, fq); S.done(cur); }
        if (!has_next) break;
#pragma unroll
        for (int a = 0; a < 2; ++a)
#pragma unroll
            for (int b = 0; b < 2; ++b)
#pragma unroll
                for (int m = 0; m < 4; ++m)
#pragma unroll
                    for (int n = 0; n < 2; ++n) acc[a][b][m][n] = (f32x4){0.f, 0.f, 0.f, 0.f};
        cur = nxt; cA = nA; cB = nB; ++ui;
        if constexpr (ALIGN_EPI) { if (wr == 1) PG8_BAR; }
    }
    PG8_WAIT_V(0);
    if constexpr (!ALIGN_EPI) { if (wr == 0) PG8_BAR; }
    PG8_BAR;
    if constexpr (Epi::AFTER_DRAIN) { E.fused(acc, cur, wr, wc, fr, fq, lds, wid, lane); S.done(cur); }
#undef PG8_SA
#undef PG8_SB
#undef PG8_STAGE
#undef PG8_LDA
#undef PG8_LDB
#undef PG8_MMA
#undef PG8_WAIT_V
#undef PG8_WAIT_L
#undef PG8_BAR
#undef PG8_SCHED
}

}

#define LAS __attribute__((address_space(3)))
typedef unsigned short bf16;
typedef unsigned v4u __attribute__((ext_vector_type(4)));
typedef unsigned v2u __attribute__((ext_vector_type(2)));
typedef float f32x4 __attribute__((ext_vector_type(4)));
typedef float f32x2 __attribute__((ext_vector_type(2)));
typedef short bf16x8 __attribute__((ext_vector_type(8)));
typedef short bf16x4 __attribute__((ext_vector_type(4)));

constexpr int NTHR = 512;
constexpr int D = 1024, SEQ = 8192, M = 16384, CTXR = 512;
constexpr int NP = 5120;
constexpr int CQ = 0, CK = 256, CV = 512, CZB = 1024, CUA = 1536, CVA = 2048, CZA = 2560, CG = 3072;
constexpr int INW = 5152;
constexpr float EPS = 1e-6f;
constexpr size_t MiB = 1u << 20;
constexpr size_t WS_MOD = 0, WS_MODC = 32768, WS_LRC = 65536, WS_PCKV = 131072, WS_LR = 1 * MiB, WS_PART = 3 * MiB, WS_DEC = 4 * MiB, WS_TOT = 4 * MiB + 640 * 1024, WS_BAR = 4 * MiB + 960 * 1024, WS_MODP = 5 * MiB + 512 * 1024,
                 WS_WSB = 5 * MiB, WS_WLR = 5 * MiB + 256 * 1024, WS_W2T = 6 * MiB, WS_WOT = 8 * MiB, WS_WIT = 10 * MiB, WS_KV = 20 * MiB, WS_MBUF = 20 * MiB,
                 WS_P = 54 * MiB, WS_END = 214 * MiB;
constexpr size_t OUT_H = 0, OUT_SB = 32 * MiB;
constexpr int NSLOT = 132;
constexpr int LDS_BYTES = 157696;

struct Params {
    const float *x, *c, *ctx, *c_ctx, *w_mod, *b_mod, *norm_g, *w_in, *a_ln_g, *a_ln_b, *a_ws, *a_bs, *gw2, *gb, *bng, *wpa, *wpb, *w_out, *fng;
    float* out; unsigned char* ws; int ph_lo, ph_hi;
};

__device__ __forceinline__ unsigned pk2(float lo, float hi) { return pg8::cvt_pk_bf16(lo, hi); }
__device__ __forceinline__ float bflo(unsigned u) { return __builtin_bit_cast(float, u << 16); }
__device__ __forceinline__ float bfhi(unsigned u) { return __builtin_bit_cast(float, u & 0xffff0000u); }
__device__ __forceinline__ float bf1(bf16 b) { return __builtin_bit_cast(float, ((unsigned)b) << 16); }
__device__ __forceinline__ float wave_sum(float v) {
#pragma unroll
    for (int o = 1; o < 64; o <<= 1) v += __shfl_xor(v, o);
    return v;
}
__device__ __forceinline__ float sigmoidf_(float v) { return __builtin_amdgcn_rcpf(1.0f + __expf(-v)); }
__device__ __forceinline__ float siluf_(float v) { return v * sigmoidf_(v); }
__device__ __forceinline__ float logsigf_(float v) { return fminf(v, 0.0f) - __logf(1.0f + __expf(-fabsf(v))); }
#define MFMA16(a, b, c) __builtin_amdgcn_mfma_f32_16x16x32_bf16((a), (b), (c), 0, 0, 0)
#define LDS_WAIT() asm volatile("s_waitcnt lgkmcnt(0)" ::: "memory")

#define XB_TMO      128
#define XB_XCNT(j)  (256  + 64 * (j))
#define XB_XSUB(j)  (1280 + 64 * (j))
#define XB_XGEN(j)  (2304 + 64 * (j))
#define XB_TOP      3328
#define XB_TOPGEN   3392
#define XCD_BAR_WORDS 3456
#define XB_SPIN_CAP (1u << 18)

__device__ __forceinline__ unsigned xb_ld(unsigned* p)              { return __hip_atomic_load(p, __ATOMIC_RELAXED, __HIP_MEMORY_SCOPE_AGENT); }
__device__ __forceinline__ unsigned xb_add(unsigned* p, unsigned v) { return __hip_atomic_fetch_add(p, v, __ATOMIC_RELAXED, __HIP_MEMORY_SCOPE_AGENT); }
__device__ __forceinline__ unsigned xb_xcc_id() { return (unsigned)__builtin_amdgcn_s_getreg((3 << 11) | 20) & 0xFu; }
#define XB_SPIN(cond, bar) do { unsigned _sp = 0; while (cond) { __builtin_amdgcn_s_sleep(1); \
    if ((++_sp & 255u) == 0u) { if (xb_ld(&(bar)[XB_TMO])) break; if (_sp > XB_SPIN_CAP) { atomicAdd(&(bar)[XB_TMO], 1u); break; } } } } while (0)

struct XcdBarrier {
    unsigned* bar; unsigned x;
    volatile LAS unsigned* st;
};

__device__ __forceinline__ XcdBarrier xcd_barrier_post(unsigned* bar, volatile LAS unsigned* st) {
    XcdBarrier b; b.bar = bar; b.x = xb_xcc_id(); b.st = st;
    if (threadIdx.x == 0) (void)xb_add(&bar[XB_XCNT(b.x)], 1u);
    return b;
}
__device__ __forceinline__ void xcd_barrier_complete(unsigned* bar, unsigned x, unsigned& nloc, unsigned& nx) {
    const unsigned G = gridDim.x * gridDim.y * gridDim.z;
    unsigned sum, cnt, mine, sp = 0u;
    for (;;) {
        sum = 0u; cnt = 0u; mine = 0u;
#pragma unroll
        for (unsigned j = 0; j < 16; ++j) { const unsigned c = xb_ld(&bar[XB_XCNT(j)]); sum += c; cnt += (c > 0u) ? 1u : 0u; mine = (j == x) ? c : mine; }
        if (sum == G) break;
        __builtin_amdgcn_s_sleep(1);
        if ((++sp & 255u) == 0u) { if (xb_ld(&bar[XB_TMO])) break; if (sp > XB_SPIN_CAP) { atomicAdd(&bar[XB_TMO], 1u); break; } }
    }
    nloc = mine > 0u ? mine : 1u; nx = cnt > 0u ? cnt : 1u;
}

__device__ __forceinline__ void xcd_barrier(const XcdBarrier& b) {
    asm volatile("s_waitcnt vmcnt(0)" ::: "memory");
    __syncthreads();
    if (threadIdx.x == 0) {
        unsigned* bar = b.bar;
        __builtin_amdgcn_s_waitcnt(0);
        unsigned nloc = b.st[0], nx = b.st[1];
        if (nloc == 0u) { xcd_barrier_complete(bar, b.x, nloc, nx); b.st[0] = nloc; b.st[1] = nx; }
        const unsigned old = xb_add(&bar[XB_XSUB(b.x)], 1u);
        const unsigned gen = old / nloc;
        if (old + 1u == (gen + 1u) * nloc) {
            __builtin_amdgcn_fence(__ATOMIC_RELEASE, "agent");
            asm volatile("s_waitcnt vmcnt(0)" ::: "memory");
            const unsigned og = xb_add(&bar[XB_TOP], 1u);
            const unsigned tg = og / nx;
            if (og + 1u == (tg + 1u) * nx) xb_add(&bar[XB_TOPGEN], 1u);
            else XB_SPIN(xb_ld(&bar[XB_TOPGEN]) == tg, bar);
            __builtin_amdgcn_fence(__ATOMIC_ACQUIRE, "agent");
            xb_add(&bar[XB_XGEN(b.x)], 1u);
            asm volatile("s_waitcnt vmcnt(0)" ::: "memory");
        } else {
            XB_SPIN(xb_ld(&bar[XB_XGEN(b.x)]) == gen, bar);
            __builtin_amdgcn_fence(__ATOMIC_ACQUIRE, "agent");
            asm volatile("s_waitcnt vmcnt(0)" ::: "memory");
        }
    }
    __syncthreads();
}

__device__ __forceinline__ void transpose_item(const float* W, int ldw, int k0, int n0, bf16* WT, int ldt, int drow0, int dk0, LAS float* scr, int lane) {
    float tv[32];
#pragma unroll
    for (int i = 0; i < 32; ++i) tv[i] = __builtin_nontemporal_load(W + (size_t)(k0 + 2 * i + (lane >> 5)) * ldw + n0 + (lane & 31));
#pragma unroll
    for (int i = 0; i < 32; ++i) scr[(2 * i + (lane >> 5)) * 33 + (lane & 31)] = tv[i];
    LDS_WAIT(); asm volatile("" ::: "memory");
    const int c = lane & 7;
#pragma unroll
    for (int j = 0; j < 4; ++j) { const int n = (lane >> 3) + 8 * j; const LAS float* s = scr + (8 * c) * 33 + n;
        v4u o; o.x = pk2(s[0 * 33], s[1 * 33]); o.y = pk2(s[2 * 33], s[3 * 33]); o.z = pk2(s[4 * 33], s[5 * 33]); o.w = pk2(s[6 * 33], s[7 * 33]);
        *(v4u*)(WT + (size_t)(drow0 + n) * ldt + dk0 + 8 * c) = o; }
    LDS_WAIT(); asm volatile("" ::: "memory");
}

__device__ __forceinline__ void phase0(const Params& p, LAS unsigned char* lds) {
    const int tid = threadIdx.x, lane = tid & 63, wave = tid >> 6, bid = blockIdx.x, G = gridDim.x;
    unsigned char* ws = p.ws;
    float* MODP = (float*)(ws + WS_MODP);
    for (int item = bid; item < 192; item += G) {
        const int cg = item >> 1, ks = item & 1;
        LAS float* s = (LAS float*)lds;
        for (int i = tid; i < 1536; i += NTHR) { const int v = i >> 9, k = ks * 512 + (i & 511); const float x = v < 2 ? p.c[v * 1024 + k] : p.c_ctx[k]; s[i] = siluf_(x); }
        __syncthreads();
        const int cc = tid & 31, kq = tid >> 5, col = cg * 32 + cc;
        float a0 = 0.f, a1 = 0.f, a2 = 0.f;
        const float* wp = p.w_mod + (size_t)(ks * 512 + kq) * 3072 + col;
        float wv[32];
#pragma unroll
        for (int i = 0; i < 32; ++i) wv[i] = wp[(size_t)i * 16 * 3072];
#pragma unroll
        for (int i = 0; i < 32; ++i) { const float w = wv[i]; const int k = kq + 16 * i; a0 += s[k] * w; a1 += s[512 + k] * w; a2 += s[1024 + k] * w; }
        LAS float* red = s + 1536;
        red[(kq * 32 + cc) * 3 + 0] = a0; red[(kq * 32 + cc) * 3 + 1] = a1; red[(kq * 32 + cc) * 3 + 2] = a2;
        __syncthreads();
        if (tid < 96) { const int c2 = tid & 31, v = tid >> 5; float sum = 0.f;
            for (int q = 0; q < 16; ++q) sum += red[(q * 32 + c2) * 3 + v];
            const int colg = cg * 32 + c2; if (ks == 0) sum += p.b_mod[colg];
            MODP[(ks * 3 + v) * 3072 + colg] = sum; }
        __syncthreads();
    }
    LAS float* scr = (LAS float*)(lds + 16384 + wave * 8704);
    const int gw = bid * 8 + wave, NGW = G * 8;
    bf16* WIT = (bf16*)(ws + WS_WIT); bf16* WLR = (bf16*)(ws + WS_WLR); bf16* W2T = (bf16*)(ws + WS_W2T); bf16* WOT = (bf16*)(ws + WS_WOT); bf16* WSB = (bf16*)(ws + WS_WSB);
    constexpr int I_IN = 16 * 161, I_A = 8 * 32, I_B = 8 * 32, I_O = 16 * 32;
    for (int it = gw; it < I_IN + I_A + I_B + I_O; it += NGW) {
        int r = it;
        if (r < I_IN) { const int kb = r / 161, nb = r % 161;
            if (nb == 32) transpose_item(p.w_in, INW, 64 * kb, 32 * nb, WLR, 1024, 0, 64 * kb, scr, lane);
            else { const int oc = 32 * (nb < 32 ? nb : nb - 1); int crow = oc;
                if (oc >= CG) { const int gi = oc - CG, c = gi & 1023; crow = CG + (c >> 7) * 256 + (gi >> 10) * 128 + (c & 127); }
                else if (oc >= CUA && oc < CVA) { const int c = oc - CUA, T = c >> 7; crow = (T < 2 ? CUA + T * 256 : CZA + (T - 2) * 256) + (c & 127); }
                else if (oc >= CZA && oc < CG) { const int c = oc - CZA, T = c >> 7; crow = (T < 2 ? CUA + T * 256 : CZA + (T - 2) * 256) + 128 + (c & 127); }
                transpose_item(p.w_in, INW, 64 * kb, 32 * nb, WIT, 1024, crow, 64 * kb, scr, lane); }
            continue; } r -= I_IN;
        if (r < I_A) { const int kb = r / 32, nb = r % 32; transpose_item(p.wpa, 1024, 64 * kb, 32 * nb, W2T, 1024, 32 * nb, 64 * kb, scr, lane); continue; } r -= I_A;
        if (r < I_B) { const int kb = r / 32, nb = r % 32; transpose_item(p.wpb, 1024, 64 * kb, 32 * nb, W2T, 1024, 32 * nb, 512 + 64 * kb, scr, lane); continue; } r -= I_B;
        { const int kb = r / 32, nb = r % 32; transpose_item(p.w_out, 1024, 64 * kb, 32 * nb, WOT, 1024, 32 * nb, 64 * kb, scr, lane); }
    }
    for (int i = bid * NTHR + tid; i < 32768; i += G * NTHR) { const f32x2 v = ((const f32x2*)p.a_ws)[i]; ((unsigned*)WSB)[i] = pk2(v.x, v.y); }
}

constexpr int HP = 2064;
__device__ __forceinline__ void phase1(const Params& p, LAS unsigned char* lds) {
    const int tid = threadIdx.x, lane = tid & 63, wave = tid >> 6, fr = lane & 15, fq = lane >> 4;
    unsigned char* ws = p.ws;
    const float* MODP = (const float*)(ws + WS_MODP);
    bf16* H = (bf16*)((unsigned char*)p.out + OUT_H);
    const bf16* WIT = (const bf16*)(ws + WS_WIT); const bf16* WLR = (const bf16*)(ws + WS_WLR);
    float* LR = (float*)(ws + WS_LR); float* LRC = (float*)(ws + WS_LRC); bf16* PCKV = (bf16*)(ws + WS_PCKV);
    for (int item = blockIdx.x; item < 480; item += gridDim.x) {
        const bool isctx = item >= 256;
        int rt = item, cgp = 0; if (isctx) { rt = (item - 256) / 7; cgp = (item - 256) % 7; }
        const int nrow = isctx ? 16 : 64, rpw = nrow >> 3;
        const float* xin = isctx ? p.ctx + (size_t)rt * 16 * 1024 : p.x + (size_t)rt * 64 * 1024;
        const int v = isctx ? 2 : (rt >> 7);
        const float* sh0 = MODP + v * 3072, *sh1 = MODP + (3 + v) * 3072;
        f32x4 gs[4], sh[4];
#pragma unroll
        for (int j = 0; j < 4; ++j) { const int ci = lane + 64 * j; const f32x4 g4 = ((const f32x4*)p.norm_g)[ci], s4 = ((const f32x4*)(sh0 + 1024))[ci] + ((const f32x4*)(sh1 + 1024))[ci];
            gs[j] = g4 * (1.0f + s4); sh[j] = ((const f32x4*)sh0)[ci] + ((const f32x4*)sh1)[ci]; }
        for (int i0 = 0; i0 < rpw; i0 += 4) {
            f32x4 xv[4][4]; const int nr = rpw - i0 < 4 ? rpw - i0 : 4;
#pragma unroll
            for (int q = 0; q < 4; ++q) if (q < nr) { const f32x4* xr = (const f32x4*)(xin + (size_t)(wave * rpw + i0 + q) * 1024);
#pragma unroll
                for (int j = 0; j < 4; ++j) xv[q][j] = __builtin_nontemporal_load(xr + lane + 64 * j); }
#pragma unroll
            for (int q = 0; q < 4; ++q) if (q < nr) { const int r = wave * rpw + i0 + q; float ss = 0.f;
#pragma unroll
                for (int j = 0; j < 4; ++j) ss += (xv[q][j].x * xv[q][j].x + xv[q][j].y * xv[q][j].y) + (xv[q][j].z * xv[q][j].z + xv[q][j].w * xv[q][j].w);
                const float rs = rsqrtf(wave_sum(ss) * (1.0f / 1024.0f) + EPS);
#pragma unroll
                for (int j = 0; j < 4; ++j) { const int col = 4 * lane + 256 * j; const f32x4 hv = xv[q][j] * rs * gs[j] + sh[j];
                    v2u o; o.x = pk2(hv.x, hv.y); o.y = pk2(hv.z, hv.w);
                    *(LAS v2u*)(lds + r * HP + col * 2) = o;
                    if (!isctx) *(v2u*)(H + (size_t)(rt * 64 + r) * 1024 + col) = o; } }
        }
        __syncthreads();
        {
            int tt, n; bool active = true;
            if (!isctx) { tt = wave >> 1; n = 768 + (wave & 1) * 16; }
            else if (cgp < 6) { tt = 0; n = cgp * 128 + wave * 16; }
            else { tt = 0; n = 768 + (wave & 1) * 16; active = wave < 2; }
            if (active) {
                const LAS unsigned char* ap = lds + (tt * 16 + fr) * HP + fq * 16;
                const bf16* bp = (n < 768 ? WIT + (size_t)(256 + n + fr) * 1024 : WLR + (size_t)(n - 768 + fr) * 1024) + fq * 8;
                f32x4 acc0 = {0.f, 0.f, 0.f, 0.f}, acc1 = {0.f, 0.f, 0.f, 0.f};
#pragma unroll
                for (int kk = 0; kk < 32; kk += 2) { const bf16x8 a0 = *(const LAS bf16x8*)(ap + kk * 64), a1 = *(const LAS bf16x8*)(ap + kk * 64 + 64);
                    const bf16x8 b0 = *(const bf16x8*)(bp + kk * 32), b1 = *(const bf16x8*)(bp + kk * 32 + 32); acc0 = MFMA16(a0, b0, acc0); acc1 = MFMA16(a1, b1, acc1); }
                const f32x4 acc = acc0 + acc1;
#pragma unroll
                for (int j = 0; j < 4; ++j) { const int rl = tt * 16 + fq * 4 + j;
                    if (!isctx) LR[(size_t)(rt * 64 + rl) * 32 + (n - 768) + fr] = acc[j];
                    else if (n < 768) PCKV[(size_t)(rt * 16 + rl) * 768 + n + fr] = (bf16)(pk2(acc[j], 0.f) & 0xffffu);
                    else LRC[(size_t)(rt * 16 + rl) * 32 + (n - 768) + fr] = acc[j]; }
            }
        }
        __syncthreads();
    }
}

typedef const __attribute__((address_space(4))) float cfloat_t;
typedef const __attribute__((address_space(4))) f32x4 cf32x4_t;
__device__ __forceinline__ cfloat_t* uniform_const_ptr(const float* p) {
    const unsigned long long a = (unsigned long long)p;
    unsigned lo = __builtin_amdgcn_readfirstlane((unsigned)a), hi = __builtin_amdgcn_readfirstlane((unsigned)(a >> 32));
    asm volatile("" : "+s"(lo), "+s"(hi));
    return (cfloat_t*)(((unsigned long long)hi << 32) | (unsigned long long)lo);
}
#define GLA_LA(la, lrs, dir, dkt, W2, GB) do { \
    float w2c[16]; _Pragma("unroll") for (int r_ = 0; r_ < 16; ++r_) w2c[r_] = (W2)[((dir) * 16 + r_) * 256 + (dkt)]; \
    const float gbv_ = (GB)[(dir) * 256 + (dkt)]; \
    _Pragma("unroll") for (int t_ = 0; t_ < 64; ++t_) { \
        const LAS f32x4* l4_ = (const LAS f32x4*)((lrs) + t_ * 32 + (dir) * 16); float lg_ = gbv_; \
        _Pragma("unroll") for (int r4_ = 0; r4_ < 4; ++r4_) { const f32x4 x_ = l4_[r4_]; lg_ += x_.x * w2c[4 * r4_] + x_.y * w2c[4 * r4_ + 1] + x_.z * w2c[4 * r4_ + 2] + x_.w * w2c[4 * r4_ + 3]; } \
        la[t_] = logsigf_(lg_) * 0.0625f; } } while (0)

constexpr int TP = 72;
__device__ __forceinline__ void stage_vT(const bf16* vptr, int pitch, LAS bf16* vT, int tid) {
    const bf16* src = vptr + tid;
    unsigned r[64];
#pragma unroll
    for (int t = 0; t < 64; ++t) r[t] = src[(size_t)t * pitch];
#pragma unroll
    for (int j = 0; j < 8; ++j) { v4u o; o.x = r[8 * j] | (r[8 * j + 1] << 16); o.y = r[8 * j + 2] | (r[8 * j + 3] << 16); o.z = r[8 * j + 4] | (r[8 * j + 5] << 16); o.w = r[8 * j + 6] | (r[8 * j + 7] << 16);
        *(LAS v4u*)(vT + tid * TP + 8 * j) = o; }
}

__device__ __forceinline__ void gate_tile(const float* lrp, const float* gw2, const float* gb, int d, int c0, int crow0, LAS bf16* laT, int fr, int fq) {
    bf16x8 Bw = {0, 0, 0, 0, 0, 0, 0, 0};
    if ((fq >> 1) == d) { const float* wp = gw2 + (size_t)(d * 16 + (fq & 1) * 8) * 256 + c0 + fr; float w[8];
#pragma unroll
        for (int e = 0; e < 8; ++e) w[e] = wp[e * 256];
        v4u t; t.x = pk2(w[0], w[1]); t.y = pk2(w[2], w[3]); t.z = pk2(w[4], w[5]); t.w = pk2(w[6], w[7]); Bw = __builtin_bit_cast(bf16x8, t); }
    const float gbv = gb[d * 256 + c0 + fr];
#pragma unroll
    for (int tt = 0; tt < 4; ++tt) {
        const f32x4 a0 = *(const f32x4*)(lrp + (size_t)(tt * 16 + fr) * 32 + fq * 8), a1 = *(const f32x4*)(lrp + (size_t)(tt * 16 + fr) * 32 + fq * 8 + 4);
        v4u t; t.x = pk2(a0.x, a0.y); t.y = pk2(a0.z, a0.w); t.z = pk2(a1.x, a1.y); t.w = pk2(a1.z, a1.w);
        f32x4 acc = {0.f, 0.f, 0.f, 0.f}; acc = MFMA16(__builtin_bit_cast(bf16x8, t), Bw, acc);
        v2u o; o.x = pk2(logsigf_(acc[0] + gbv) * 0.0625f, logsigf_(acc[1] + gbv) * 0.0625f); o.y = pk2(logsigf_(acc[2] + gbv) * 0.0625f, logsigf_(acc[3] + gbv) * 0.0625f);
        *(LAS v2u*)(laT + (crow0 + fr) * TP + tt * 16 + fq * 4) = o; }
}

template <int NC> __device__ __forceinline__ void stage_nat(const bf16* src, int pitch, LAS unsigned char* X, int LPB, int tid) {
    constexpr int PPR = NC / 8, NPT = 64 * PPR / 512;
#pragma unroll
    for (int i = 0; i < NPT; ++i) { const int id = tid + 512 * i, row = id / PPR, pc = id % PPR;
        *(LAS v4u*)(X + row * LPB + pc * 16) = *(const v4u*)(src + (size_t)row * pitch + pc * 8); }
}
__device__ __forceinline__ void col_to_row(const LAS unsigned char* X, int LPB, int c, LAS bf16* dst) {
    unsigned r[64];
#pragma unroll
    for (int t = 0; t < 64; ++t) r[t] = *(const LAS bf16*)(X + t * LPB + c * 2);
#pragma unroll
    for (int j = 0; j < 8; ++j) { v4u o; o.x = r[8 * j] | (r[8 * j + 1] << 16); o.y = r[8 * j + 2] | (r[8 * j + 3] << 16); o.z = r[8 * j + 4] | (r[8 * j + 5] << 16); o.w = r[8 * j + 6] | (r[8 * j + 7] << 16);
        *(LAS v4u*)(dst + 8 * j) = o; }
}

template <int MODE> __device__ __forceinline__ void phase3a(const Params& p, LAS unsigned char* lds, bool do_ln) {
    const int tid = threadIdx.x, lane = tid & 63, wave = tid >> 6, fr = lane & 15, fq = lane >> 4;
    unsigned char* ws = p.ws;
    bf16* P = (bf16*)(ws + WS_P); const bf16* PCKV = (const bf16*)(ws + WS_PCKV);
    const float* LR = (const float*)(ws + WS_LR); const float* LRC = (const float*)(ws + WS_LRC);
    bf16* KV = (bf16*)(ws + (MODE ? 214 * MiB : WS_KV)); float* DEC = (float*)(ws + (MODE ? 250 * MiB : WS_DEC)); float* TOT = (float*)(ws + (MODE ? 252 * MiB : WS_TOT));
    LAS float* lrs = (LAS float*)lds; LAS bf16* kT = (LAS bf16*)(lds + 8192); LAS bf16* vT = (LAS bf16*)(lds + 8192 + 73728);
    for (int item = blockIdx.x; item < 256; item += gridDim.x) {
        const bf16 *kptr, *vptr; const float* lrp; int pitch, slot, b;
        if (item < 256) { b = item >> 7; const int n = item & 127; const size_t row0 = (size_t)b * SEQ + n * 64; kptr = P + row0 * NP + CK; vptr = P + row0 * NP + CV; pitch = NP; lrp = LR + row0 * 32; slot = 4 + n; }
        else { const int cc = item - 256; b = cc >> 2; const int n = cc & 3; const size_t row0 = (size_t)b * 256 + n * 64; kptr = PCKV + row0 * 768; vptr = kptr + 256; pitch = 768; lrp = LRC + row0 * 32; slot = n; }
        int tl = tid; asm volatile("" : "+v"(tl));
        LAS unsigned char* X = (LAS unsigned char*)kT;
        stage_nat<512>(vptr, pitch, X, 1040, tl);
        __syncthreads();
        col_to_row(X, 1040, tl, vT + tl * TP);
        __syncthreads();
        stage_nat<256>(kptr, pitch, X, 528, tl);
        __syncthreads();
        {
            const int dir = tl >> 8, dkt = tl & 255;
            unsigned kraw[64];
#pragma unroll
            for (int t = 0; t < 64; ++t) kraw[t] = *(const LAS bf16*)(X + t * 528 + dkt * 2);
            __syncthreads();
            float la[64];
            {
                const int fr2 = tl & 15, fq2 = (tl >> 4) & 3, wv = __builtin_amdgcn_readfirstlane(tl >> 6);
#pragma unroll
                for (int j = 0; j < 4; ++j) { const int c = (wv * 4 + j) * 16; gate_tile(lrp, p.gw2, p.gb, c >> 8, c & 255, c, kT, fr2, fq2); }
                __syncthreads();
#pragma unroll
                for (int j = 0; j < 8; ++j) { const v4u r = *(const LAS v4u*)(kT + tl * TP + 8 * j);
                    la[8 * j] = bflo(r.x); la[8 * j + 1] = bfhi(r.x); la[8 * j + 2] = bflo(r.y); la[8 * j + 3] = bfhi(r.y); la[8 * j + 4] = bflo(r.z); la[8 * j + 5] = bfhi(r.z); la[8 * j + 6] = bflo(r.w); la[8 * j + 7] = bfhi(r.w); }
                __syncthreads();
            }
            float run = 0.f;
#pragma unroll
            for (int t = 0; t < 64; ++t) { const float l = la[t]; run += l; la[t] = dir ? (run - l) : run; }
            const float total = run;
            DEC[(size_t)(dir * 2 * NSLOT + b * NSLOT + slot) * 256 + dkt] = __expf(total);
            if (dir && item < 256) TOT[(size_t)item * 256 + dkt] = total;
            unsigned w[32];
#pragma unroll
            for (int t = 0; t < 32; ++t) {
                const float e0 = dir ? la[2 * t] : total - la[2 * t], e1 = dir ? la[2 * t + 1] : total - la[2 * t + 1];
                const float k0 = __builtin_bit_cast(float, kraw[2 * t] << 16), k1 = __builtin_bit_cast(float, kraw[2 * t + 1] << 16);
#if defined(P3A_KONLY)
                w[t] = pk2(k0, k1); }
#elif defined(P3A_SYNTH)
                w[t] = pk2((float)((tid * 7 + t * 3) & 63) * 0.125f, (float)((tid * 5 + t) & 31) * 0.25f); }
#elif defined(P3A_EONLY)
                w[t] = pk2(__expf(e0), __expf(e1)); }
#else
                w[t] = pk2(k0 * __expf(e0), k1 * __expf(e1)); }
#endif
#pragma unroll
            for (int j = 0; j < 8; ++j) { v4u o; o.x = w[4 * j]; o.y = w[4 * j + 1]; o.z = w[4 * j + 2]; o.w = w[4 * j + 3]; *(LAS v4u*)(kT + tl * TP + 8 * j) = o; }
        }
        __syncthreads();
        if (MODE != 3) {
            const int dir = wave >> 2, h = wave & 3;
            bf16* kvo = KV + ((size_t)(dir * 2 * NSLOT + b * NSLOT + slot) * 4 + h) * 8192;
            bf16x8 A[4][2];
#pragma unroll
            for (int mi = 0; mi < 4; ++mi)
#pragma unroll
                for (int kk = 0; kk < 2; ++kk) A[mi][kk] = *(const LAS bf16x8*)(kT + (dir * 256 + h * 64 + mi * 16 + fr) * TP + kk * 32 + fq * 8);
#ifdef P3A_CONST_K
#pragma unroll
            for (int mi = 0; mi < 4; ++mi) { A[mi][0] = (bf16x8){0x3f80, 0x3f80, 0x3f80, 0x3f80, 0x3f80, 0x3f80, 0x3f80, 0x3f80}; A[mi][1] = A[mi][0]; }
#endif
            f32x4 acc[8][4];
#pragma unroll
            for (int ni = 0; ni < 8; ++ni) {
                bf16x8 B[2];
#pragma unroll
                for (int kk = 0; kk < 2; ++kk) B[kk] = *(const LAS bf16x8*)(vT + (h * 128 + ni * 16 + fr) * TP + kk * 32 + fq * 8);
#pragma unroll
                for (int mi = 0; mi < 4; ++mi) { f32x4 c = {0.f, 0.f, 0.f, 0.f}; c = MFMA16(A[mi][0], B[0], c); acc[ni][mi] = MFMA16(A[mi][1], B[1], c); }
            }
            __syncthreads();
            LAS bf16* sl = kT + wave * (128 * TP);
#pragma unroll
            for (int ni = 0; ni < 8; ++ni)
#pragma unroll
                for (int mi = 0; mi < 4; ++mi) { v2u o; o.x = pk2(acc[ni][mi][0], acc[ni][mi][1]); o.y = pk2(acc[ni][mi][2], acc[ni][mi][3]);
                    *(LAS v2u*)(sl + (ni * 16 + fr) * TP + mi * 16 + fq * 4) = o; }
            LDS_WAIT(); asm volatile("" ::: "memory");
#pragma unroll
            for (int i = 0; i < 16; ++i) { const int id = lane + 64 * i, row = id >> 3, part = id & 7;
                *(v4u*)(kvo + (size_t)row * 64 + part * 8) = *(const LAS v4u*)(sl + row * TP + part * 8); }
        }
        __syncthreads();
    }
    for (int sub = blockIdx.x; sub < 64; sub += gridDim.x) {
        const int cc = sub >> 3, dir = (sub >> 2) & 1, h = sub & 3, b = cc >> 2, slot = cc & 3;
        const size_t row0 = (size_t)b * 256 + slot * 64;
        const bf16* kptr = PCKV + row0 * 768; const bf16* vptr = kptr + 256; const float* lrp = LRC + row0 * 32;
        int tl = tid; asm volatile("" : "+v"(tl));
        const int wv = __builtin_amdgcn_readfirstlane(tl >> 6), fr2 = tl & 15, fq2 = (tl >> 4) & 3;
        { const int ch = tl & 127, tq = tl >> 7; const bf16* src = vptr + (size_t)(tq * 16) * 768 + h * 128 + ch; unsigned r[16];
#pragma unroll
          for (int t = 0; t < 16; ++t) r[t] = src[(size_t)t * 768];
#pragma unroll
          for (int j = 0; j < 2; ++j) { v4u o; o.x = r[8 * j] | (r[8 * j + 1] << 16); o.y = r[8 * j + 2] | (r[8 * j + 3] << 16); o.z = r[8 * j + 4] | (r[8 * j + 5] << 16); o.w = r[8 * j + 6] | (r[8 * j + 7] << 16);
              *(LAS v4u*)(vT + (h * 128 + ch) * TP + tq * 16 + 8 * j) = o; } }
        if (wv < 4) { const int c0 = h * 64 + wv * 16; gate_tile(lrp, p.gw2, p.gb, dir, c0, dir * 256 + c0, kT, fr2, fq2); }
        __syncthreads();
        if (wv == 0) {
            const int dkt = h * 64 + tl, crow = dir * 256 + dkt;
            unsigned kraw[64];
#pragma unroll
            for (int t = 0; t < 64; ++t) kraw[t] = kptr[(size_t)t * 768 + dkt];
            float la[64];
#pragma unroll
            for (int j = 0; j < 8; ++j) { const v4u r = *(const LAS v4u*)(kT + crow * TP + 8 * j);
                la[8 * j] = bflo(r.x); la[8 * j + 1] = bfhi(r.x); la[8 * j + 2] = bflo(r.y); la[8 * j + 3] = bfhi(r.y); la[8 * j + 4] = bflo(r.z); la[8 * j + 5] = bfhi(r.z); la[8 * j + 6] = bflo(r.w); la[8 * j + 7] = bfhi(r.w); }
            float run = 0.f;
#pragma unroll
            for (int t = 0; t < 64; ++t) { const float l = la[t]; run += l; la[t] = dir ? (run - l) : run; }
            const float total = run;
            DEC[(size_t)(dir * 2 * NSLOT + b * NSLOT + slot) * 256 + dkt] = __expf(total);
            unsigned w[32];
#pragma unroll
            for (int t = 0; t < 32; ++t) {
                const float e0 = dir ? la[2 * t] : total - la[2 * t], e1 = dir ? la[2 * t + 1] : total - la[2 * t + 1];
                w[t] = pk2(__builtin_bit_cast(float, kraw[2 * t] << 16) * __expf(e0), __builtin_bit_cast(float, kraw[2 * t + 1] << 16) * __expf(e1)); }
#pragma unroll
            for (int j = 0; j < 8; ++j) { v4u o; o.x = w[4 * j]; o.y = w[4 * j + 1]; o.z = w[4 * j + 2]; o.w = w[4 * j + 3]; *(LAS v4u*)(kT + crow * TP + 8 * j) = o; }
        }
        __syncthreads();
        {
            bf16* kvo = KV + ((size_t)(dir * 2 * NSLOT + b * NSLOT + slot) * 4 + h) * 8192;
            bf16x8 B[2]; f32x4 acc[4];
#pragma unroll
            for (int kk = 0; kk < 2; ++kk) B[kk] = *(const LAS bf16x8*)(vT + (h * 128 + wv * 16 + fr2) * TP + kk * 32 + fq2 * 8);
#pragma unroll
            for (int mi = 0; mi < 4; ++mi) { const LAS bf16* ar = kT + (dir * 256 + h * 64 + mi * 16 + fr2) * TP + fq2 * 8;
                f32x4 c = {0.f, 0.f, 0.f, 0.f}; c = MFMA16(*(const LAS bf16x8*)ar, B[0], c); acc[mi] = MFMA16(*(const LAS bf16x8*)(ar + 32), B[1], c); }
            __syncthreads();
            LAS bf16* sl = kT + wv * (16 * TP);
#pragma unroll
            for (int mi = 0; mi < 4; ++mi) { v2u o; o.x = pk2(acc[mi][0], acc[mi][1]); o.y = pk2(acc[mi][2], acc[mi][3]); *(LAS v2u*)(sl + fr2 * TP + mi * 16 + fq2 * 4) = o; }
            LDS_WAIT(); asm volatile("" ::: "memory");
#pragma unroll
            for (int i = 0; i < 2; ++i) { const int id = (tl & 63) + 64 * i, row = id >> 3, part = id & 7;
                *(v4u*)(kvo + (size_t)(wv * 16 + row) * 64 + part * 8) = *(const LAS v4u*)(sl + row * TP + part * 8); }
        }
        __syncthreads();
    }
    if (do_ln) {
        const int nskip = (int)gridDim.x > 128 ? 64 : 0;
        const int gw = ((int)blockIdx.x - nskip) * 8 + wave, NGW = ((int)gridDim.x - nskip) * 8;
        float g[8], bb[8];
#pragma unroll
        for (int i = 0; i < 8; ++i) { g[i] = p.a_ln_g[lane * 8 + i]; bb[i] = p.a_ln_b[lane * 8 + i]; }
        if (gw >= 0) for (int row = gw; row < M; row += NGW) {
            v4u* pp = (v4u*)(P + (size_t)row * NP + CVA) + lane; const v4u raw = *pp;
            float v[8] = {bflo(raw.x), bfhi(raw.x), bflo(raw.y), bfhi(raw.y), bflo(raw.z), bfhi(raw.z), bflo(raw.w), bfhi(raw.w)};
            float s = 0.f;
#pragma unroll
            for (int i = 0; i < 8; ++i) s += v[i];
            const float mean = wave_sum(s) * (1.0f / 512.0f); float s2 = 0.f;
#pragma unroll
            for (int i = 0; i < 8; ++i) { v[i] -= mean; s2 += v[i] * v[i]; }
            const float rstd = rsqrtf(wave_sum(s2) * (1.0f / 512.0f) + EPS);
#pragma unroll
            for (int i = 0; i < 8; ++i) v[i] = v[i] * rstd * g[i] + bb[i];
            v4u o; o.x = pk2(v[0], v[1]); o.y = pk2(v[2], v[3]); o.z = pk2(v[4], v[5]); o.w = pk2(v[6], v[7]); *pp = o;
        }
    }
}

__device__ __forceinline__ void phase3b(const Params& p) {
    unsigned char* ws = p.ws;
    const bf16* KV = (const bf16*)(ws + WS_KV); const float* DEC = (const float*)(ws + WS_DEC);
    bf16* SB = (bf16*)((unsigned char*)p.out + OUT_SB);
    for (int e = blockIdx.x * NTHR + threadIdx.x; e < 131072; e += gridDim.x * NTHR) {
        const int dk = e & 63, dv = (e >> 6) & 127, h = (e >> 13) & 3, b = (e >> 15) & 1, dir = e >> 16;
        const size_t kvb = ((size_t)(dir * 2 * NSLOT + b * NSLOT) * 4 + h) * 8192 + dv * 64 + dk;
        const size_t dcb = (size_t)(dir * 2 * NSLOT + b * NSLOT) * 256 + h * 64 + dk;
        const size_t sbb = ((size_t)((dir * 2 + b) * 128) * 4 + h) * 8192 + dv * 64 + dk;
        float s0 = 0.f;
        for (int u0 = 0; u0 < 132; u0 += 12) {
            bf16 kvv[12]; float dc[12];
#pragma unroll
            for (int j = 0; j < 12; ++j) { const int u = u0 + j, slot = dir ? (u < 4 ? 3 - u : 135 - u) : u;
                kvv[j] = KV[kvb + (size_t)slot * 32768]; dc[j] = DEC[dcb + (size_t)slot * 256]; }
#pragma unroll
            for (int j = 0; j < 12; ++j) { const int u = u0 + j, slot = dir ? (u < 4 ? 3 - u : 135 - u) : u;
                if (u >= 4) SB[sbb + (size_t)(slot - 4) * 32768] = (bf16)(pk2(s0, 0.f) & 0xffffu);
                s0 = dc[j] * s0 + bf1(kvv[j]); }
        }
    }
}

constexpr int QP = 264;
template <int MODE> __device__ __forceinline__ void phase3c(const Params& p, LAS unsigned char* lds) {
    const int tid = threadIdx.x, lane = tid & 63, wave = tid >> 6, fr = lane & 15, fq = lane >> 4;
    unsigned char* ws = p.ws;
    const bf16* P = (const bf16*)(ws + WS_P); const float* LR = (const float*)(ws + WS_LR);
    const bf16* SB = (const bf16*)((unsigned char*)p.out + OUT_SB); bf16* A2 = MODE ? (bf16*)(ws + 214 * MiB) : (bf16*)((unsigned char*)p.out + OUT_H);
    const bf16* WSB = (const bf16*)(ws + WS_WSB); const float* TOT = (const float*)(ws + WS_TOT);
    LAS float* lrs = (LAS float*)lds; LAS bf16* qd = (LAS bf16*)(lds + 8192); LAS bf16* kd = (LAS bf16*)(lds + 8192 + 33792); LAS bf16* vT = (LAS bf16*)(lds + 8192 + 2 * 33792);
    for (int item = blockIdx.x; item < 256; item += gridDim.x) {
        const int b = item >> 7, n = item & 127; const size_t row0 = (size_t)b * SEQ + n * 64;
        const bf16* prow = P + row0 * NP;
        LAS unsigned char* X = (LAS unsigned char*)qd;
        if (MODE != 5) { int ts = tid; asm volatile("" : "+v"(ts));
          stage_nat<512>(prow + CV, NP, X, 1040, ts);
          __syncthreads();
          col_to_row(X, 1040, ts, vT + ts * TP); }
        const int h = wave >> 1, th = wave & 1;
        f32x4 oacc[8][2];
#pragma unroll
        for (int a = 0; a < 8; ++a)
#pragma unroll
            for (int c = 0; c < 2; ++c) oacc[a][c] = (f32x4){0.f, 0.f, 0.f, 0.f};
#pragma unroll 1
        for (int dir = 0; dir < 2; ++dir) {
            __syncthreads();
            int tl = tid; asm volatile("" : "+v"(tl));
            const int fr = tl & 15, fq = (tl >> 4) & 3;
            if (MODE != 2) {
                const int role = tl >> 8, dkt = tl & 255;
                const float total = dir ? TOT[(size_t)(b * 128 + n) * 256 + dkt] : 0.f;
                const bf16* src = prow + (role ? CK : CQ) + dkt; LAS bf16* dst = (role ? kd : qd) + dkt;
                const float sgn = role ? -1.0f : 1.0f, mul = role ? 1.0f : 0.125f;
                stage_nat<512>(prow + CQ, NP, X, 1040, tl);
                __syncthreads();
                unsigned raw[64];
#pragma unroll
                for (int t = 0; t < 64; ++t) raw[t] = *(const LAS bf16*)(X + t * 1040 + (role * 256 + dkt) * 2);
                __syncthreads();
                { const int wv = __builtin_amdgcn_readfirstlane(tl >> 6);
#pragma unroll
                  for (int j = 0; j < 2; ++j) { const int c = (wv * 2 + j) * 16; gate_tile(LR + row0 * 32, p.gw2, p.gb, dir, c, c, qd, fr, fq); } }
                __syncthreads();
                v4u lap[8];
#pragma unroll
                for (int j = 0; j < 8; ++j) lap[j] = *(const LAS v4u*)(qd + dkt * TP + 8 * j);
                __syncthreads();
                float run = 0.f;
#pragma unroll
                for (int t = 0; t < 64; ++t) {
                    const unsigned pr = lap[t >> 3][(t >> 1) & 3];
                    const float l = (t & 1) ? bfhi(pr) : bflo(pr);
                    const float cq = dir ? (total - run) : (run + l);
                    run += l;
                    const float v = __builtin_bit_cast(float, raw[t] << 16) * mul * __expf(sgn * cq);
                    dst[t * QP] = (bf16)(pk2(v, 0.f) & 0xffffu); }
            }
            __syncthreads();
            if (MODE != 3) {
                bf16x8 As[8][2];
                { const bf16* sbq = SB + ((size_t)(((dir * 2 + b) * 128 + n) * 4) + h) * 8192 + (size_t)fr * 64 + fq * 8;
#pragma unroll
                  for (int dvt = 0; dvt < 8; ++dvt)
#pragma unroll
                      for (int kk = 0; kk < 2; ++kk) As[dvt][kk] = *(const bf16x8*)(sbq + (size_t)dvt * 1024 + kk * 32); }
                bf16x8 Bq[2][2];
#pragma unroll
                for (int tt = 0; tt < 2; ++tt)
#pragma unroll
                    for (int kk = 0; kk < 2; ++kk) Bq[tt][kk] = *(const LAS bf16x8*)(qd + (th * 32 + tt * 16 + fr) * QP + h * 64 + kk * 32 + fq * 8);
                unsigned pj[4][2][2];
#pragma unroll
                for (int jj = 0; jj < 4; ++jj) {
                    bf16x8 Ak[2];
#pragma unroll
                    for (int kk = 0; kk < 2; ++kk) Ak[kk] = *(const LAS bf16x8*)(kd + (jj * 16 + fr) * QP + h * 64 + kk * 32 + fq * 8);
#pragma unroll
                    for (int tt = 0; tt < 2; ++tt) { f32x4 st = {0.f, 0.f, 0.f, 0.f}; st = MFMA16(Ak[0], Bq[tt][0], st); st = MFMA16(Ak[1], Bq[tt][1], st);
                        const int t = th * 32 + tt * 16 + fr, j0 = jj * 16 + fq * 4;
#pragma unroll
                        for (int i = 0; i < 4; ++i) { const bool keep = dir ? (j0 + i >= t) : (j0 + i <= t); st[i] = keep ? st[i] : 0.f; }
                        pj[jj][tt][0] = pk2(st[0], st[1]); pj[jj][tt][1] = pk2(st[2], st[3]); }
                }
#pragma unroll
                for (int dvt = 0; dvt < 8; ++dvt) {
                    const LAS bf16* vrow = vT + (h * 128 + dvt * 16 + fr) * TP + fq * 4;
#pragma unroll
                    for (int ks = 0; ks < 2; ++ks) {
                        const v2u a0 = *(const LAS v2u*)(vrow + (2 * ks) * 16), a1 = *(const LAS v2u*)(vrow + (2 * ks + 1) * 16);
                        v4u av; av.x = a0.x; av.y = a0.y; av.z = a1.x; av.w = a1.y;
                        const bf16x8 Av = __builtin_bit_cast(bf16x8, av);
#pragma unroll
                        for (int tt = 0; tt < 2; ++tt) { v4u bv; bv.x = pj[2 * ks][tt][0]; bv.y = pj[2 * ks][tt][1]; bv.z = pj[2 * ks + 1][tt][0]; bv.w = pj[2 * ks + 1][tt][1];
                            oacc[dvt][tt] = MFMA16(Av, __builtin_bit_cast(bf16x8, bv), oacc[dvt][tt]); }
                    }
#pragma unroll
                    for (int kk = 0; kk < 2; ++kk) {
#pragma unroll
                        for (int tt = 0; tt < 2; ++tt) oacc[dvt][tt] = MFMA16(As[dvt][kk], Bq[tt][kk], oacc[dvt][tt]); }
                }
            }
        }
        if (MODE != 4) {
            int te = tid; asm volatile("" : "+v"(te)); const int fr = te & 15, fq = (te >> 4) & 3;
            v2u zz[2][8]; f32x4 gg[8];
#pragma unroll
            for (int dvt = 0; dvt < 8; ++dvt) { gg[dvt] = *(const f32x4*)(p.bng + h * 128 + dvt * 16 + fq * 4);
#pragma unroll
                for (int tt = 0; tt < 2; ++tt) zz[tt][dvt] = *(const v2u*)(P + (row0 + th * 32 + tt * 16 + fr) * NP + CZB + h * 128 + dvt * 16 + fq * 4); }
#pragma unroll
            for (int tt = 0; tt < 2; ++tt) {
                float ss = 0.f;
#pragma unroll
                for (int dvt = 0; dvt < 8; ++dvt) { const f32x4 o = oacc[dvt][tt]; ss += (o[0] * o[0] + o[1] * o[1]) + (o[2] * o[2] + o[3] * o[3]); }
                ss += __shfl_xor(ss, 16); ss += __shfl_xor(ss, 32);
                const float rstd = rsqrtf(ss * (1.0f / 128.0f) + EPS);
                const size_t row = row0 + th * 32 + tt * 16 + fr;
#pragma unroll
                for (int dvt = 0; dvt < 8; ++dvt) { const int cc = h * 128 + dvt * 16 + fq * 4;
                    const v2u z = zz[tt][dvt]; const f32x4 g = gg[dvt]; const f32x4 o = oacc[dvt][tt];
                    v2u w; w.x = pk2(o[0] * rstd * g.x * bflo(z.x), o[1] * rstd * g.y * bfhi(z.x));
                    w.y = pk2(o[2] * rstd * g.z * bflo(z.y), o[3] * rstd * g.w * bfhi(z.y));
                    *(v2u*)(A2 + row * 1024 + 512 + cc) = w; }
            }
        }
        __syncthreads();
    }
    constexpr int VP = 136;
    LAS bf16* vnT = (LAS bf16*)lds;
    if (MODE == 0) for (int item = blockIdx.x; item < 512; item += gridDim.x) {
        const int b = item >> 8, g = (item >> 6) & 3, ci = item & 63;
        const size_t base = (size_t)b * SEQ + (g < 2 ? ci * 128 : ci); const int stride = g < 2 ? 1 : 64;
        {
            const int c = tid & 127, jq = tid >> 7;
            const bf16* src = P + (base + (size_t)(jq * 32) * stride) * NP + CVA + g * 128 + c;
            unsigned w[16];
#pragma unroll
            for (int j = 0; j < 16; ++j) { const unsigned a = src[(size_t)(2 * j) * stride * NP], bq = src[(size_t)(2 * j + 1) * stride * NP]; w[j] = a | (bq << 16); }
#pragma unroll
            for (int j = 0; j < 4; ++j) { v4u o; o.x = w[4 * j]; o.y = w[4 * j + 1]; o.z = w[4 * j + 2]; o.w = w[4 * j + 3]; *(LAS v4u*)(vnT + c * VP + jq * 32 + 8 * j) = o; }
        }
        __syncthreads();
        {
            bf16x8 Bw[4];
#pragma unroll
            for (int kk = 0; kk < 4; ++kk) Bw[kk] = *(const bf16x8*)(WSB + (size_t)(g * 128 + wave * 16 + fr) * 128 + kk * 32 + fq * 8);
            const size_t tok = base + (size_t)(wave * 16 + fr) * stride;
            const float bsv = p.a_bs[g * 128 + wave * 16 + fr];
#pragma unroll
            for (int ct = 0; ct < 8; ++ct) {
                f32x4 acc = {0.f, 0.f, 0.f, 0.f};
#pragma unroll
                for (int kk = 0; kk < 4; ++kk) { const bf16x8 Av = *(const LAS bf16x8*)(vnT + (ct * 16 + fr) * VP + kk * 32 + fq * 8); acc = MFMA16(Av, Bw[kk], acc); }
                const int cc = g * 128 + ct * 16 + fq * 4;
                const v2u u = *(const v2u*)(P + tok * NP + (g < 2 ? CUA + g * 256 : CZA + (g - 2) * 256) + ct * 16 + fq * 4);
                v2u w; w.x = pk2(bflo(u.x) * (acc[0] + bsv), bfhi(u.x) * (acc[1] + bsv));
                w.y = pk2(bflo(u.y) * (acc[2] + bsv), bfhi(u.y) * (acc[3] + bsv));
                *(v2u*)(A2 + tok * 1024 + cc) = w;
            }
        }
        __syncthreads();
    }
}

struct EpiP {
    static constexpr bool PERM = true, AFTER_DRAIN = false, MID = false;
    bf16* O;
    __device__ __forceinline__ void mid(pg8::f32x4 (&)[2][2][4][2], const pg8::Unit&, int, int, int, int) const {}
    __device__ __forceinline__ void operator()(pg8::f32x4 (&acc)[2][2][4][2], const pg8::Unit& u, int wr, int wc, int fr, int fq) const {
        const int row0 = u.pm * 256 + wr * 64 + fr, col0 = u.pn * 256 + wc * 32 + 8 * fq;
#pragma unroll
        for (int ai = 0; ai < 2; ++ai)
#pragma unroll
            for (int m = 0; m < 4; ++m) { bf16* rowp = O + (size_t)(row0 + ai * 128 + m * 16) * NP + col0;
                pg8::f32x4 g00 = acc[ai][0][m][0], g01 = acc[ai][0][m][1], g10 = acc[ai][1][m][0], g11 = acc[ai][1][m][1];
                if (u.pn >= CG / 256) {
#pragma unroll
                    for (int k = 0; k < 4; ++k) {
                        const float ea = __expf(-g10[k]), sa = __builtin_amdgcn_rcpf(1.0f + __expf(-g00[k])); g00[k] = sa * (1.0f + ea); g10[k] = __builtin_amdgcn_rcpf(1.0f + ea);
                        const float eb = __expf(-g11[k]), sb = __builtin_amdgcn_rcpf(1.0f + __expf(-g01[k])); g01[k] = sb * (1.0f + eb); g11[k] = __builtin_amdgcn_rcpf(1.0f + eb); } }
                if ((u.pn == CZB / 256) | (u.pn == CZB / 256 + 1)) {
#pragma unroll
                    for (int k = 0; k < 4; ++k) { g00[k] *= __builtin_amdgcn_rcpf(1.0f + __expf(-g00[k])); g01[k] *= __builtin_amdgcn_rcpf(1.0f + __expf(-g01[k])); g10[k] *= __builtin_amdgcn_rcpf(1.0f + __expf(-g10[k])); g11[k] *= __builtin_amdgcn_rcpf(1.0f + __expf(-g11[k])); } }
                const bool uz = (u.pn == CUA / 256) | (u.pn == CUA / 256 + 1) | (u.pn == CZA / 256) | (u.pn == CZA / 256 + 1);
                if (uz) {
#pragma unroll
                    for (int k = 0; k < 4; ++k) { g00[k] = g00[k] * g10[k] * __builtin_amdgcn_rcpf(1.0f + __expf(-g10[k])); g01[k] = g01[k] * g11[k] * __builtin_amdgcn_rcpf(1.0f + __expf(-g11[k])); } }
                { v4u w; w.x = pk2(g00[0], g00[1]); w.y = pk2(g00[2], g00[3]); w.z = pk2(g01[0], g01[1]); w.w = pk2(g01[2], g01[3]); *(v4u*)(rowp) = w; }
                if (!uz) { v4u w; w.x = pk2(g10[0], g10[1]); w.y = pk2(g10[2], g10[3]); w.z = pk2(g11[0], g11[1]); w.w = pk2(g11[2], g11[3]); *(v4u*)(rowp + 128) = w; } }
    }
};
struct EpiMerge {
    static constexpr bool PERM = true, AFTER_DRAIN = false, MID = true;
    const bf16* P; bf16* O;
    __device__ __forceinline__ void mid(pg8::f32x4 (&acc)[2][2][4][2], const pg8::Unit& u, int wr, int wc, int fr, int fq) const {
        asm volatile("" : "+v"(fr), "+v"(fq));
        const int row0 = u.pm * 256 + wr * 64 + fr, gc0 = CG + u.pn * 512 + wc * 32 + 8 * fq;
#pragma unroll
        for (int ai = 0; ai < 2; ++ai)
#pragma unroll
            for (int m = 0; m < 4; ++m) { const bf16* gp = P + (size_t)(row0 + ai * 128 + m * 16) * NP + gc0;
#pragma unroll
                for (int bj = 0; bj < 2; ++bj) { const v4u a1 = *(const v4u*)(gp + bj * 256);
                    const float r[8] = {bflo(a1.x), bfhi(a1.x), bflo(a1.y), bfhi(a1.y), bflo(a1.z), bfhi(a1.z), bflo(a1.w), bfhi(a1.w)};
#pragma unroll
                    for (int e = 0; e < 8; ++e) acc[ai][bj][m][e >> 2][e & 3] *= r[e]; } }
    }
    __device__ __forceinline__ void operator()(pg8::f32x4 (&acc)[2][2][4][2], const pg8::Unit& u, int wr, int wc, int fr, int fq) const {
        const int row0 = u.pm * 256 + wr * 64 + fr, col0 = u.pn * 256 + wc * 32 + 8 * fq, gc0 = CG + u.pn * 512 + 128 + wc * 32 + 8 * fq;
#pragma unroll
        for (int ai = 0; ai < 2; ++ai)
#pragma unroll
            for (int m = 0; m < 4; ++m) { const size_t row = (size_t)(row0 + ai * 128 + m * 16); const bf16* gp = P + row * NP + gc0;
#pragma unroll
                for (int bj = 0; bj < 2; ++bj) { const v4u a2 = *(const v4u*)(gp + bj * 256);
                    const float s2[8] = {bflo(a2.x), bfhi(a2.x), bflo(a2.y), bfhi(a2.y), bflo(a2.z), bfhi(a2.z), bflo(a2.w), bfhi(a2.w)};
                    float o[8];
#pragma unroll
                    for (int e = 0; e < 8; ++e) o[e] = acc[ai][bj][m][e >> 2][e & 3] * s2[e];
                    v4u w; w.x = pk2(o[0], o[1]); w.y = pk2(o[2], o[3]); w.z = pk2(o[4], o[5]); w.w = pk2(o[6], o[7]);
                    *(v4u*)(O + row * 1024 + col0 + bj * 128) = w; } }
    }
};
struct EpiFinal {
    static constexpr bool PERM = false, AFTER_DRAIN = true, MID = false;
    const float *x, *MOD, *fng; float *PART, *out; int split; const XcdBarrier* bar;
    __device__ __forceinline__ void mid(pg8::f32x4 (&)[2][2][4][2], const pg8::Unit&, int, int, int, int) const {}
    __device__ __forceinline__ void operator()(pg8::f32x4 (&)[2][2][4][2], const pg8::Unit&, int, int, int, int) const {}
    __device__ __forceinline__ void fused(pg8::f32x4 (&acc)[2][2][4][2], const pg8::Unit& u, int wr, int wc, int fr, int fq, PG8_LAS unsigned char*, int, int) const {
        const int row0 = u.pm * 256 + wr * 64 + fr, col0 = u.pn * 256 + wc * 32 + 4 * fq;
        const float* gate = MOD + (u.pm >> 5) * 3072 + 2048 + col0;
        {
            f32x4 gt[2][2];
#pragma unroll
            for (int bj = 0; bj < 2; ++bj)
#pragma unroll
                for (int n = 0; n < 2; ++n) gt[bj][n] = *(const f32x4*)(gate + bj * 128 + n * 16) + *(const f32x4*)(gate + 9216 + bj * 128 + n * 16);
#pragma unroll
            for (int ai = 0; ai < 2; ++ai)
#pragma unroll
                for (int m = 0; m < 4; ++m) { const size_t row = (size_t)(row0 + ai * 128 + m * 16); const float* xr = x + row * 1024 + col0; float ss = 0.f;
#pragma unroll
                    for (int bj = 0; bj < 2; ++bj)
#pragma unroll
                        for (int n = 0; n < 2; ++n) { const f32x4 xv = *(const f32x4*)(xr + bj * 128 + n * 16); const f32x4 v = xv + gt[bj][n] * acc[ai][bj][m][n]; acc[ai][bj][m][n] = v;
                            ss += (v[0] * v[0] + v[1] * v[1]) + (v[2] * v[2] + v[3] * v[3]); }
                    ss += __shfl_xor(ss, 16); ss += __shfl_xor(ss, 32);
                    if (fq == 0) PART[((size_t)u.pn * M + row) * 4 + wc] = ss; }
        }
        if (split) {
#pragma unroll
            for (int ai = 0; ai < 2; ++ai)
#pragma unroll
                for (int m = 0; m < 4; ++m) { float* orow = out + (size_t)(row0 + ai * 128 + m * 16) * 1024 + col0;
#pragma unroll
                    for (int bj = 0; bj < 2; ++bj)
#pragma unroll
                        for (int n = 0; n < 2; ++n) *(f32x4*)(orow + bj * 128 + n * 16) = acc[ai][bj][m][n]; }
            return;
        }
        xcd_barrier(*bar);
        {
            f32x4 fg[2][2];
#pragma unroll
            for (int bj = 0; bj < 2; ++bj)
#pragma unroll
                for (int n = 0; n < 2; ++n) fg[bj][n] = *(const f32x4*)(fng + col0 + bj * 128 + n * 16);
#pragma unroll
            for (int ai = 0; ai < 2; ++ai)
#pragma unroll
                for (int m = 0; m < 4; ++m) { const size_t row = (size_t)(row0 + ai * 128 + m * 16); const f32x4* pp = (const f32x4*)(PART + row * 4);
                    const f32x4 p0 = pp[0], p1 = pp[M], p2 = pp[2 * M], p3 = pp[3 * M];
                    const float tot = ((p0[0] + p0[1]) + (p0[2] + p0[3])) + ((p1[0] + p1[1]) + (p1[2] + p1[3])) + ((p2[0] + p2[1]) + (p2[2] + p2[3])) + ((p3[0] + p3[1]) + (p3[2] + p3[3]));
                    const float rstd = rsqrtf(tot * (1.0f / 1024.0f) + EPS);
                    float* orow = out + row * 1024 + col0;
#pragma unroll
                    for (int bj = 0; bj < 2; ++bj)
#pragma unroll
                        for (int n = 0; n < 2; ++n) *(f32x4*)(orow + bj * 128 + n * 16) = acc[ai][bj][m][n] * rstd * fg[bj][n]; }
        }
    }
};

__global__ void __launch_bounds__(NTHR) fwd_megakernel(Params p) {
    extern __shared__ __attribute__((aligned(16))) unsigned char lds_raw[];
    LAS unsigned char* lds = (LAS unsigned char*)lds_raw;
    cg::grid_group grid = cg::this_grid();
    unsigned char* ws = p.ws;
#define IN(k) (p.ph_lo <= (k) && (k) < p.ph_hi)
#define SEAM(k) do { if (IN(k) && IN((k) + 1)) { xcd_barrier(xbar); } } while (0)
    volatile LAS unsigned* xst = (volatile LAS unsigned*)(lds + LDS_BYTES - 16);
    if (threadIdx.x == 0) { xst[0] = 0u; xst[1] = 0u; }
    __syncthreads();
    const XcdBarrier xbar = xcd_barrier_post((unsigned*)(ws + WS_BAR), xst);
    if (p.ph_lo < 0) grid.sync();
#ifndef PROBE
#define PROBE 0
#endif
    if (PROBE == 1) { for (int i = 0; i < 8; ++i) xcd_barrier(xbar); }
    if (IN(0)) phase0(p, lds);
    SEAM(0);
    if (PROBE == 4) { phase0(p, lds); xcd_barrier(xbar); }
    if (IN(1)) phase1(p, lds);
    SEAM(1);
    if (PROBE == 4) { phase1(p, lds); xcd_barrier(xbar); }
    if (IN(2)) {
        pg8::Gemm g{(const bf16*)((unsigned char*)p.out + OUT_H), (const bf16*)(ws + WS_WIT), M, NP, D}; pg8::StaticOrder S; S.init(M, NP, (int)gridDim.x, (int)blockIdx.x);
        EpiP E{(bf16*)(ws + WS_P)};
        pg8::gemm_phase<EpiP, pg8::StaticOrder, true, true>(lds, g, S, E);
    }
    SEAM(2);
    if (PROBE == 5) {
        pg8::Gemm g{(const bf16*)((unsigned char*)p.out + OUT_H), (const bf16*)(ws + WS_WIT), M, NP, D}; pg8::StaticOrder S; S.init(M, NP, (int)gridDim.x, (int)blockIdx.x);
        EpiP E{(bf16*)(ws + WS_P)};
        pg8::gemm_phase<EpiP, pg8::StaticOrder, true, true>(lds, g, S, E);
        xcd_barrier(xbar);
    }
    if (IN(3)) phase3a<0>(p, lds, true);
    SEAM(3);
    if (PROBE == 3) { phase3a<0>(p, lds, false); xcd_barrier(xbar); }
    if (PROBE == 11) { phase3a<1>(p, lds, false); xcd_barrier(xbar); }
    if (PROBE == 12) { phase3a<2>(p, lds, false); xcd_barrier(xbar); }
    if (PROBE == 13) { phase3a<3>(p, lds, false); xcd_barrier(xbar); }
    if (PROBE == 14) { phase3a<4>(p, lds, false); xcd_barrier(xbar); }
    if (IN(4)) phase3b(p);
    SEAM(4);
    if (PROBE == 3) { phase3b(p); xcd_barrier(xbar); }
    if (IN(5)) phase3c<0>(p, lds);
    SEAM(5);
    if (PROBE == 2) { phase3c<0>(p, lds); xcd_barrier(xbar); }
    if (PROBE == 21) { phase3c<1>(p, lds); xcd_barrier(xbar); }
    if (PROBE == 22) { phase3c<2>(p, lds); xcd_barrier(xbar); }
    if (PROBE == 23) { phase3c<3>(p, lds); xcd_barrier(xbar); }
    if (PROBE == 24) { phase3c<4>(p, lds); xcd_barrier(xbar); }
    if (PROBE == 25) { phase3c<5>(p, lds); xcd_barrier(xbar); }
    if (IN(6)) {
        pg8::Gemm g{(const bf16*)((unsigned char*)p.out + OUT_H), (const bf16*)(ws + WS_W2T), M, D, D}; pg8::StaticOrder S; S.init(M, D, (int)gridDim.x, (int)blockIdx.x);
        EpiMerge E{(const bf16*)(ws + WS_P), (bf16*)(ws + WS_MBUF)};
        pg8::gemm_phase<EpiMerge, pg8::StaticOrder, true, true>(lds, g, S, E);
    }
    SEAM(6);
    if (PROBE == 6) {
        pg8::Gemm g{(const bf16*)((unsigned char*)p.out + OUT_H), (const bf16*)(ws + WS_W2T), M, D, D}; pg8::StaticOrder S; S.init(M, D, (int)gridDim.x, (int)blockIdx.x);
        EpiMerge E{(const bf16*)(ws + WS_P), (bf16*)(ws + WS_MBUF)};
        pg8::gemm_phase<EpiMerge, pg8::StaticOrder, true, true>(lds, g, S, E);
        xcd_barrier(xbar);
    }
    if (IN(7)) {
        pg8::Gemm g{(const bf16*)(ws + WS_MBUF), (const bf16*)(ws + WS_WOT), M, D, D}; pg8::StaticOrder S; S.init(M, D, (int)gridDim.x, (int)blockIdx.x);
        EpiFinal E{p.x, (const float*)(ws + WS_MODP), p.fng, (float*)(ws + WS_PART), p.out, p.ph_hi - p.ph_lo < 9 ? 1 : 0, &xbar};
        pg8::gemm_phase<EpiFinal, pg8::StaticOrder, false, true>(lds, g, S, E);
    }
    SEAM(7);
    if (IN(8) && (p.ph_hi - p.ph_lo < 9)) {
        const int lane = threadIdx.x & 63, wave = threadIdx.x >> 6; const float* PART = (const float*)(ws + WS_PART);
        for (int row = blockIdx.x * 8 + wave; row < M; row += gridDim.x * 8) {
            const f32x4* pp = (const f32x4*)(PART + (size_t)row * 4); const f32x4 p0 = pp[0], p1 = pp[M], p2 = pp[2 * M], p3 = pp[3 * M];
            const float tot = ((p0[0] + p0[1]) + (p0[2] + p0[3])) + ((p1[0] + p1[1]) + (p1[2] + p1[3])) + ((p2[0] + p2[1]) + (p2[2] + p2[3])) + ((p3[0] + p3[1]) + (p3[2] + p3[3]));
            const float rstd = rsqrtf(tot * (1.0f / 1024.0f) + EPS);
            f32x4* orow = (f32x4*)(p.out + (size_t)row * 1024);
#pragma unroll
            for (int j = 0; j < 4; ++j) orow[lane + 64 * j] = orow[lane + 64 * j] * rstd * ((const f32x4*)p.fng)[lane + 64 * j];
        }
    }
    if (IN(9)) {
        float* o = (float*)((unsigned char*)p.out + OUT_SB); const bf16* P = (const bf16*)(ws + WS_P);
        for (size_t i = (size_t)blockIdx.x * NTHR + threadIdx.x; i < 8388608; i += (size_t)gridDim.x * NTHR) { float a = 0.f; for (int j = 0; j < 10; ++j) a += bf1(P[i * 10 + j]); o[i] = a; }
    }
    if (IN(10)) {
        float* o = (float*)((unsigned char*)p.out + OUT_SB);
        const float* LR = (const float*)(ws + WS_LR); const float* LRC = (const float*)(ws + WS_LRC); const bf16* PCKV = (const bf16*)(ws + WS_PCKV);
        const float* DEC = (const float*)(ws + WS_DEC); const float* TOT = (const float*)(ws + WS_TOT); const float* MOD = (const float*)(ws + WS_MOD); const bf16* KV = (const bf16*)(ws + WS_KV);
        const size_t g0 = (size_t)blockIdx.x * NTHR + threadIdx.x, gs = (size_t)gridDim.x * NTHR;
#ifndef DUMP_SEL
#define DUMP_SEL 63
#endif
        if (DUMP_SEL & 1) for (size_t i = g0; i < 524288; i += gs) o[i] = LR[i];
        if (DUMP_SEL & 2) for (size_t i = g0; i < 16384; i += gs) o[600000 + i] = LRC[i];
        if (DUMP_SEL & 4) for (size_t i = g0; i < 393216; i += gs) o[700000 + i] = bf1(PCKV[i]);
        if (DUMP_SEL & 8) for (size_t i = g0; i < 135168; i += gs) o[1200000 + i] = DEC[i];
        if (DUMP_SEL & 16) for (size_t i = g0; i < 65536; i += gs) o[1400000 + i] = TOT[i];
        if (DUMP_SEL & 32) for (size_t i = g0; i < 8192; i += gs) o[1500000 + i] = MOD[i < 6144 ? i : 8192 + (i - 6144)];
        if (DUMP_SEL & 128) for (size_t i = g0; i < 4325376; i += gs) { float a = 0.f; for (int j = 0; j < 4; ++j) a += bf1(KV[i * 4 + j]); if ((((i * 4) >> 13) & 3) < 2) o[2000000 + i] = a; }
        if (DUMP_SEL & 256) for (size_t i = g0; i < 4325376; i += gs) { float a = 0.f; for (int j = 0; j < 4; ++j) a += bf1(KV[i * 4 + j]); if ((((i * 4) >> 13) & 3) >= 2) o[2000000 + i] = a; }
        if (DUMP_SEL & 64) for (size_t i = g0; i < 4325376; i += gs) { float a = 0.f; for (int j = 0; j < 4; ++j) a += bf1(KV[i * 4 + j]); o[2000000 + i] = a; }
    }
#undef IN
#undef SEAM
}

extern "C" void kernel_launch(void* const* d_in, const int* in_sizes, int n_in, void* d_out, int out_size, void* d_ws, size_t ws_size, hipStream_t stream) {
    static int grid = 0;
    if (grid == 0) {
        if (n_in != 19 || out_size != M * D || ws_size < WS_END) { fprintf(stderr, "kernel_launch: unexpected shapes (n_in %d out %d ws %zu)\n", n_in, out_size, ws_size); grid = -1; return; }
        int dev = 0, cus = 0, per_cu = 0;
        hipGetDevice(&dev); hipDeviceGetAttribute(&cus, hipDeviceAttributeMultiprocessorCount, dev);
        if (hipFuncSetAttribute((const void*)fwd_megakernel, hipFuncAttributeMaxDynamicSharedMemorySize, LDS_BYTES) != hipSuccess) { fprintf(stderr, "kernel_launch: hipFuncSetAttribute failed\n"); grid = -1; return; }
        hipOccupancyMaxActiveBlocksPerMultiprocessor(&per_cu, (const void*)fwd_megakernel, NTHR, LDS_BYTES);
        if (cus * per_cu < 256) { fprintf(stderr, "kernel_launch: need 256 co-resident workgroups, have %d x %d\n", cus, per_cu); grid = -1; return; }
        grid = 256;
    }
    if (grid < 0) return;
    Params p{};
    p.x = (const float*)d_in[0]; p.c = (const float*)d_in[1]; p.ctx = (const float*)d_in[2]; p.c_ctx = (const float*)d_in[3]; p.w_mod = (const float*)d_in[4]; p.b_mod = (const float*)d_in[5];
    p.norm_g = (const float*)d_in[6]; p.w_in = (const float*)d_in[7]; p.a_ln_g = (const float*)d_in[8]; p.a_ln_b = (const float*)d_in[9]; p.a_ws = (const float*)d_in[10]; p.a_bs = (const float*)d_in[11];
    p.gw2 = (const float*)d_in[12]; p.gb = (const float*)d_in[13]; p.bng = (const float*)d_in[14]; p.wpa = (const float*)d_in[15]; p.wpb = (const float*)d_in[16]; p.w_out = (const float*)d_in[17]; p.fng = (const float*)d_in[18];
    p.out = (float*)d_out; p.ws = (unsigned char*)d_ws;
#ifndef MK_CUTS
#define MK_CUTS 1
#endif
#ifndef MK_DBG
#define MK_DBG 0
#endif
#ifndef MK_SEQ
#define MK_SEQ 0, 1, 10
#endif
    const int seq_dbg[] = {MK_SEQ}; const int nseq = (int)(sizeof(seq_dbg) / sizeof(int));
    if (hipMemsetAsync((unsigned char*)d_ws + WS_BAR, 0, XCD_BAR_WORDS * 4, stream) != hipSuccess) { fprintf(stderr, "kernel_launch: memset failed\n"); return; }
    for (int li = 0; li < (MK_DBG ? nseq : MK_CUTS); ++li) {
        p.ph_lo = (MK_CUTS == 1) ? 0 : li; p.ph_hi = (MK_CUTS == 1) ? 9 : li + 1;
        if (MK_DBG) { p.ph_lo = seq_dbg[li]; p.ph_hi = seq_dbg[li] + 1; }
        void* args[] = {&p};
        hipError_t e = hipLaunchCooperativeKernel((const void*)fwd_megakernel, dim3(grid), dim3(NTHR), args, LDS_BYTES, stream);
        if (e != hipSuccess) fprintf(stderr, "cooperative launch failed: %s\n", hipGetErrorString(e));
    }
}
```
